# Optimizing an MI355X kernel written in HIP

```python
import jax, jax.numpy as jnp
from jax import lax
import numpy as np


D_MODEL = 4096
BATCH = 4
SEQ = 2048
DEPTH = 1

GM_WIDTH = 2048
GM_GROUPS = 8
GM_GROUP_W = GM_WIDTH // GM_GROUPS
CHUNK = 128
MLA_HEADS = 32
QK_NOPE = 128
QK_ROPE = 64
QK_HEAD = QK_NOPE + QK_ROPE
V_HEAD = 128
Q_LORA = 1024
KV_LORA = 512
ROPE_THETA = 10000.0
Q_BLOCK = 128
D_FF = 4 * D_MODEL
N_BRANCH = 2
N_MOD = 6
EPS = 1e-6
OFF_Q = 2 * GM_WIDTH
OFF_KV = OFF_Q + Q_LORA
OFF_KPE = OFF_KV + KV_LORA
OFF_GATE = OFF_KPE + QK_ROPE
IN_COLS = OFF_GATE + N_BRANCH * D_MODEL

kernel_name = 'hybrid_gmlp_mla_block'


def rms_norm(x, g):
    xf = x.astype(jnp.float32)
    y = xf * lax.rsqrt(jnp.mean(xf * xf, axis=-1, keepdims=True) + EPS)
    return (y * g.astype(jnp.float32)).astype(x.dtype)


def modulate(h, shift, scale):
    return h * (1 + scale[:, None, :]) + shift[:, None, :]


def rope_tables(positions, dtype):
    inv_freq = 1.0 / (ROPE_THETA ** (jnp.arange(0, QK_ROPE, 2, dtype=jnp.float32) / QK_ROPE))
    ang = positions.astype(jnp.float32)[..., None] * inv_freq
    return (jnp.cos(ang)[:, :, None, :].astype(dtype),
            jnp.sin(ang)[:, :, None, :].astype(dtype))


def apply_rope(x, cos, sin):
    x1, x2 = jnp.split(x, 2, axis=-1)
    return jnp.concatenate([x1 * cos - x2 * sin, x2 * cos + x1 * sin], axis=-1)


def gmlp_branch(uv, g_v, w_s, b_s):
    z = jax.nn.gelu(uv, approximate=False)
    u, v = z[..., :GM_WIDTH], z[..., GM_WIDTH:]
    v = rms_norm(v, g_v)
    b, s, _ = v.shape
    v = v.reshape(b, s // CHUNK, CHUNK, GM_GROUPS, GM_GROUP_W)
    causal = jnp.tril(jnp.ones((CHUNK, CHUNK), dtype=bool))
    w = jnp.where(causal[None], w_s, 0.0)
    mixed = jnp.einsum('gts,bnsgc->bntgc', w, v) + b_s.T[None, None, :, :, None]
    return u * mixed.reshape(b, s, GM_WIDTH)


def mla_branch(q_lat, kv_lat, k_pe, cos, sin, g_q_lat, g_kv_lat, w_uq, w_ukv, g_qn, g_kn):
    b, s, _ = q_lat.shape
    q = (rms_norm(q_lat, g_q_lat) @ w_uq).reshape(b, s, MLA_HEADS, QK_HEAD)
    kv = (rms_norm(kv_lat, g_kv_lat) @ w_ukv).reshape(b, s, MLA_HEADS, QK_NOPE + V_HEAD)
    k_nope, v = kv[..., :QK_NOPE], kv[..., QK_NOPE:]
    k = jnp.concatenate([k_nope, jnp.broadcast_to(k_pe[:, :, None, :], (b, s, MLA_HEADS, QK_ROPE))], axis=-1)
    q = rms_norm(q, g_qn)
    k = rms_norm(k, g_kn)
    q = jnp.concatenate([q[..., :QK_NOPE], apply_rope(q[..., QK_NOPE:], cos, sin)], axis=-1)
    k = jnp.concatenate([k[..., :QK_NOPE], apply_rope(k[..., QK_NOPE:], cos, sin)], axis=-1)
    q = q.transpose(0, 2, 1, 3)
    k = k.transpose(0, 2, 1, 3)
    v = v.transpose(0, 2, 1, 3)
    nb = s // Q_BLOCK
    q_blocks = q.reshape(b, MLA_HEADS, nb, Q_BLOCK, QK_HEAD).transpose(2, 0, 1, 3, 4)
    key_idx = jnp.arange(s)
    scale = QK_HEAD ** -0.5

    def attend(args):
        q_blk, i = args
        q_idx = i * Q_BLOCK + jnp.arange(Q_BLOCK)
        scores = jnp.einsum('bhqd,bhkd->bhqk', q_blk, k).astype(jnp.float32) * scale
        scores = jnp.where(key_idx[None, :] <= q_idx[:, None], scores, -jnp.inf)
        p = jax.nn.softmax(scores, axis=-1).astype(v.dtype)
        return jnp.einsum('bhqk,bhkd->bhqd', p, v)

    out = lax.map(attend, (q_blocks, jnp.arange(nb)))
    return out.transpose(1, 0, 3, 2, 4).reshape(b, s, MLA_HEADS * V_HEAD)


def setup_inputs(seed: int = 0) -> dict:
    key = jax.random.key(seed)
    ks = jax.random.split(key, 24)
    f32 = jnp.float32

    def nrm(k, shape, fan_in):
        return jax.random.normal(k, shape, f32) * (fan_in ** -0.5)

    def gain(k, shape):
        return 1.0 + 0.02 * jax.random.normal(k, shape, f32)

    L = DEPTH
    x = jax.random.normal(ks[0], (BATCH, SEQ, D_MODEL), f32)
    c = jax.random.normal(ks[1], (BATCH, D_MODEL), f32)
    positions = (jnp.arange(SEQ, dtype=jnp.int32)[None, :]
                 + jax.random.randint(ks[2], (BATCH, 1), 0, 4096, dtype=jnp.int32))
    return {
        'x': x,
        'c': c,
        'positions': positions,
        'w_ada': nrm(ks[3], (L, D_MODEL, N_MOD * D_MODEL), D_MODEL),
        'b_ada': 0.02 * jax.random.normal(ks[4], (L, N_MOD * D_MODEL), f32),
        'g_norm1': gain(ks[5], (L, D_MODEL)),
        'w_in': nrm(ks[6], (L, D_MODEL, IN_COLS), D_MODEL),
        'g_v': gain(ks[7], (L, GM_WIDTH)),
        'w_s': nrm(ks[8], (L, GM_GROUPS, CHUNK, CHUNK), CHUNK),
        'b_s': 1.0 + 0.1 * jax.random.normal(ks[9], (L, GM_GROUPS, CHUNK), f32),
        'g_q_lat': gain(ks[10], (L, Q_LORA)),
        'g_kv_lat': gain(ks[11], (L, KV_LORA)),
        'w_uq': nrm(ks[12], (L, Q_LORA, MLA_HEADS * QK_HEAD), Q_LORA),
        'w_ukv': nrm(ks[13], (L, KV_LORA, MLA_HEADS * (QK_NOPE + V_HEAD)), KV_LORA),
        'g_qn': gain(ks[14], (L, QK_HEAD)),
        'g_kn': gain(ks[15], (L, QK_HEAD)),
        'w_branch_a': nrm(ks[16], (L, GM_WIDTH, D_MODEL), GM_WIDTH),
        'w_branch_b': nrm(ks[17], (L, MLA_HEADS * V_HEAD, D_MODEL), MLA_HEADS * V_HEAD),
        'w_out': nrm(ks[18], (L, D_MODEL, D_MODEL), D_MODEL),
        'g_norm2': gain(ks[19], (L, D_MODEL)),
        'w_ff1': nrm(ks[20], (L, D_MODEL, D_FF), D_MODEL),
        'w_ff2': nrm(ks[21], (L, D_FF, D_MODEL), D_FF),
    }


def reference(x, c, positions, w_ada, b_ada, g_norm1, w_in, g_v, w_s, b_s, g_q_lat, g_kv_lat,
              w_uq, w_ukv, g_qn, g_kn, w_branch_a, w_branch_b, w_out, g_norm2, w_ff1, w_ff2):
    cos, sin = rope_tables(positions, x.dtype)
    cond = jax.nn.silu(c)
    for l in range(DEPTH):
        mod = cond @ w_ada[l] + b_ada[l]
        sh1, sc1, ga1, sh2, sc2, ga2 = jnp.split(mod, N_MOD, axis=-1)
        h = modulate(rms_norm(x, g_norm1[l]), sh1, sc1)
        proj = h @ w_in[l]
        y_a = gmlp_branch(proj[..., :OFF_Q], g_v[l], w_s[l], b_s[l]) @ w_branch_a[l]
        y_b = mla_branch(proj[..., OFF_Q:OFF_KV], proj[..., OFF_KV:OFF_KPE], proj[..., OFF_KPE:OFF_GATE],
                         cos, sin, g_q_lat[l], g_kv_lat[l], w_uq[l], w_ukv[l], g_qn[l], g_kn[l]) @ w_branch_b[l]
        gate_a = jax.nn.sigmoid(proj[..., OFF_GATE:OFF_GATE + D_MODEL])
        gate_b = jax.nn.sigmoid(proj[..., OFF_GATE + D_MODEL:])
        mixed = gate_a * y_a + gate_b * y_b
        x = x + ga1[:, None, :] * (mixed @ w_out[l])
        h = modulate(rms_norm(x, g_norm2[l]), sh2, sc2)
        ff = jnp.square(jax.nn.relu(h @ w_ff1[l])) @ w_ff2[l]
        x = x + ga2[:, None, :] * ff
    return x
```

```cpp
#include <hip/hip_runtime.h>
#include <cstdio>
#include <cstdint>
#include <cmath>

#ifndef DIAG_STOP
#define DIAG_STOP -1
#endif
#ifndef PG8_SP2
#define PG8_SP2 true
#endif
#ifndef PG8_ALIGN
#define PG8_ALIGN true
#endif
#ifndef PG8_WGM
#define PG8_WGM 16
#endif
#ifndef PROBE_REDO
#define PROBE_REDO -1
#endif
#ifndef MK_N_LAUNCHES
#define MK_N_LAUNCHES 1
#endif

constexpr int UV8 = 4096;
namespace pg8 {
__device__ __forceinline__ int lane_id() { int l; asm volatile("v_mbcnt_lo_u32_b32 %0, -1, 0\n\tv_mbcnt_hi_u32_b32 %0, -1, %0" : "=v"(l)); return l; }
#define PG8_LAS __attribute__((address_space(3)))
typedef unsigned short bf16_t;
typedef short bf16x8 __attribute__((ext_vector_type(8)));
typedef float f32x4 __attribute__((ext_vector_type(4)));
typedef float f32x2 __attribute__((ext_vector_type(2)));
typedef unsigned u32x4 __attribute__((ext_vector_type(4)));
typedef unsigned u32x2 __attribute__((ext_vector_type(2)));
typedef int i32x4 __attribute__((ext_vector_type(4)));
constexpr int BM = 256, BK = 64, HALF = 128, HTB = HALF * BK * 2, STAGE_BYTES = 8 * HTB, NXCD = 8, WGM = PG8_WGM;

__host__ __device__ __forceinline__ int lds_byte(int r, int c) { const int st = (r >> 4) * 2 + (c >> 5), rr = r & 15, cc = c & 31, ob = rr * 64 + cc * 2; return st * 1024 + (ob ^ (((ob >> 9) & 1) << 5)); }
__host__ __device__ __forceinline__ void stage_rc(int b, int& R, int& C) { const int st = b / 1024, sb = b % 1024, swz = sb ^ (((sb >> 9) & 1) << 5); R = (st >> 1) * 16 + swz / 64; C = (st & 1) * 32 + (swz % 64) / 2; }
__host__ __device__ __forceinline__ int perm32(int rho) { const int n = rho >> 4, i = rho & 15; return 8 * (i >> 2) + 4 * n + (i & 3); }

struct Unit { int pm, pn; };
struct Gemm { const bf16_t* A; const bf16_t* Bt; int lda, ldb; int M, N, K; };

struct StaticOrder {
    int nM, nN, nwg, G, c;
    __host__ __device__ void init(int M, int N, int G_, int c_) { nM = M / BM; nN = N / BM; nwg = nM * nN; G = G_; c = c_; }
    __host__ __device__ bool next(int i, Unit& u) const {
        const long L = (long)i * G + c; if (L >= nwg) return false;
        int wgid = (int)L; { const int q = nwg / NXCD, r = nwg % NXCD, xcd = wgid % NXCD, off = wgid / NXCD; wgid = (xcd < r ? xcd * (q + 1) : r * (q + 1) + (xcd - r) * q) + off; }
        const int nig = WGM * nN, gid = wgid / nig, fm = gid * WGM, gsz = (nM - fm) < WGM ? (nM - fm) : WGM;
        u.pm = fm + ((wgid % nig) % gsz); u.pn = (wgid % nig) / gsz; return true;
    }
};

typedef __bf16 bf16x2_t __attribute__((ext_vector_type(2)));
__device__ __forceinline__ unsigned cvt_pk_bf16(float lo, float hi) { f32x2 v = {lo, hi}; bf16x2_t b = __builtin_convertvector(v, bf16x2_t); return __builtin_bit_cast(unsigned, b); }
__device__ __forceinline__ u32x4 pack8(f32x4 a, f32x4 b) { u32x4 w; w.x = cvt_pk_bf16(a[0], a[1]); w.y = cvt_pk_bf16(a[2], a[3]); w.z = cvt_pk_bf16(b[0], b[1]); w.w = cvt_pk_bf16(b[2], b[3]); return w; }
__device__ __forceinline__ float bf_lo(unsigned w) { return __uint_as_float(w << 16); }
__device__ __forceinline__ float bf_hi(unsigned w) { return __uint_as_float(w & 0xffff0000u); }
__device__ __forceinline__ f32x2 gelu_pk(f32x2 v) {
    const f32x2 av = __builtin_elementwise_abs(v), d = av * 0.2316418882f + 1.0f;
    f32x2 t; t.x = __builtin_amdgcn_rcpf(d.x); t.y = __builtin_amdgcn_rcpf(d.y);
    f32x2 q = t * 0.5307027145f + (-0.7265760135f); q = q * t + 0.7107068705f; q = q * t + (-0.142248368f); q = q * t + 0.127414796f; q = q * t;
    const f32x2 s = (v * v) * (-0.72134752044f);
    f32x2 e; e.x = __builtin_amdgcn_exp2f(s.x); e.y = __builtin_amdgcn_exp2f(s.y);
    const f32x2 m = v * (q * e), r = v - m;
    f32x2 o; o.x = v.x < 0.f ? m.x : r.x; o.y = v.y < 0.f ? m.y : r.y; return o;
}
template <int ACT> __device__ __forceinline__ f32x4 act4(f32x4 v) {
    if constexpr (ACT == 1) { const f32x2 a = gelu_pk((f32x2){v[0], v[1]}), b = gelu_pk((f32x2){v[2], v[3]}); return (f32x4){a.x, a.y, b.x, b.y}; }
    else if constexpr (ACT == 2) { f32x4 o;
#pragma unroll
        for (int i = 0; i < 4; ++i) o[i] = __builtin_amdgcn_rcpf(1.0f + __builtin_amdgcn_exp2f(-1.4426950408889634f * v[i])); return o; }
    else if constexpr (ACT == 3) { f32x4 o;
#pragma unroll
        for (int i = 0; i < 4; ++i) { const float r = v[i] > 0.f ? v[i] : 0.f; o[i] = r * r; } return o; }
    else return v;
}

template <int ACT> __device__ __forceinline__ void store_tile_bf16(const f32x4 (&acc)[2][2][4][2], bf16_t* dst, int ld, int row0, int col0) {
#pragma unroll
    for (int ai = 0; ai < 2; ++ai)
#pragma unroll
        for (int m = 0; m < 4; ++m) { bf16_t* rowp = dst + (size_t)(row0 + ai * HALF + m * 16) * ld + col0;
#pragma unroll
            for (int bj = 0; bj < 2; ++bj) *(u32x4*)(rowp + bj * HALF) = pack8(act4<ACT>(acc[ai][bj][m][0]), act4<ACT>(acc[ai][bj][m][1])); }
}
struct EpiProj {
    static constexpr bool PERM = true;
    bf16_t *UV, *QL, *KVL, *KPE, *GATES; int pn0;
    __device__ __forceinline__ void operator()(const f32x4 (&acc)[2][2][4][2], const Unit& u, int wr, int wc, int fr, int fq) const {
        const int row0 = u.pm * BM + wr * 64 + fr, cw = wc * 32 + 8 * fq, pn = u.pn + pn0;
        if (pn < 16) store_tile_bf16<1>(acc, UV, 4096, row0, pn * BM + cw);
        else if (pn < 20) store_tile_bf16<0>(acc, QL, 1024, row0, (pn - 16) * BM + cw);
        else if (pn < 22) store_tile_bf16<0>(acc, KVL, 512, row0, (pn - 20) * BM + cw);
        else if (pn == 22) store_tile_bf16<0>(acc, KPE, 256, row0, cw);
        else store_tile_bf16<2>(acc, GATES, 8192, row0, (pn - 23) * BM + cw);
    }
};
template <int ACT> struct EpiRowScale {
    static constexpr bool PERM = true;
    bf16_t* O; int ld; const float* rs;
    __device__ __forceinline__ void operator()(const f32x4 (&acc)[2][2][4][2], const Unit& u, int wr, int wc, int fr, int fq) const {
        const int row0 = u.pm * BM + wr * 64 + fr, col0 = u.pn * BM + wc * 32 + 8 * fq;
#pragma unroll
        for (int ai = 0; ai < 2; ++ai)
#pragma unroll
            for (int m = 0; m < 4; ++m) { const int row = row0 + ai * HALF + m * 16; const float s = rs ? rs[row] : 1.0f; bf16_t* rowp = O + (size_t)row * ld + col0;
#pragma unroll
                for (int bj = 0; bj < 2; ++bj) *(u32x4*)(rowp + bj * HALF) = pack8(act4<ACT>(acc[ai][bj][m][0] * s), act4<ACT>(acc[ai][bj][m][1] * s)); }
    }
};
struct EpiKV {
    static constexpr bool PERM = true;
    bf16_t *K, *V; const float *rkv, *rpe, *per, *g_kn; PG8_LAS float* P;
    __device__ __forceinline__ void operator()(const f32x4 (&acc)[2][2][4][2], const Unit& u, int wr, int wc, int fr, int fq) const {
        const int rl0 = wr * 64 + fr, row0 = u.pm * BM + rl0, h = u.pn, cw = wc * 32 + 8 * fq;
#pragma unroll
        for (int ai = 0; ai < 2; ++ai)
#pragma unroll
            for (int m = 0; m < 4; ++m) { const f32x4 a = acc[ai][0][m][0], b = acc[ai][0][m][1];
                float s = (a[0] * a[0] + a[1] * a[1]) + (a[2] * a[2] + a[3] * a[3]) + (b[0] * b[0] + b[1] * b[1]) + (b[2] * b[2] + b[3] * b[3]);
                s += __shfl_xor(s, 16); s += __shfl_xor(s, 32);
                if (fq == 0) P[(ai * HALF + rl0 + m * 16) * 4 + wc] = s; }
        asm volatile("s_waitcnt lgkmcnt(0)" ::: "memory"); __builtin_amdgcn_s_barrier(); asm volatile("" ::: "memory");
        const f32x4 g0 = *(const f32x4*)(g_kn + cw), g1 = *(const f32x4*)(g_kn + cw + 4);
#pragma unroll
        for (int ai = 0; ai < 2; ++ai)
#pragma unroll
            for (int m = 0; m < 4; ++m) { const int rl = ai * HALF + rl0 + m * 16, row = u.pm * BM + rl; const float s = rkv[row];
                const f32x4 ps = *(const PG8_LAS f32x4*)(P + rl * 4);
                const float rk = s / sqrtf((((ps[0] + ps[1]) + (ps[2] + ps[3])) * s * s + rpe[row]) * (1.0f / 192.0f) + 1e-6f);
                *(u32x4*)(K + (size_t)row * 6144 + h * 192 + cw) = pack8(acc[ai][0][m][0] * rk * g0, acc[ai][0][m][1] * rk * g1);
                *(u32x4*)(V + (size_t)row * 4096 + h * 128 + cw) = pack8(acc[ai][1][m][0] * s, acc[ai][1][m][1] * s); }
        { const int tid = (wr * 4 + wc) * 64 + fq * 16 + fr, rl = tid >> 1, part = tid & 1, row = u.pm * BM + rl; const float s = rkv[row];
          const f32x4 ps = *(const PG8_LAS f32x4*)(P + rl * 4);
          const float rk = 1.0f / sqrtf((((ps[0] + ps[1]) + (ps[2] + ps[3])) * s * s + rpe[row]) * (1.0f / 192.0f) + 1e-6f);
          const float* pp = per + (size_t)row * 64 + part * 32; bf16_t* kp = K + (size_t)row * 6144 + h * 192 + 128 + part * 32;
#pragma unroll
          for (int j = 0; j < 4; ++j) { const f32x4 a = *(const f32x4*)(pp + 8 * j), b = *(const f32x4*)(pp + 8 * j + 4); *(u32x4*)(kp + 8 * j) = pack8(a * rk, b * rk); } }
    }
};
struct EpiGateF32 {
    static constexpr bool PERM = true;
    float* T; const bf16_t* G;
    __device__ __forceinline__ void operator()(const f32x4 (&acc)[2][2][4][2], const Unit& u, int wr, int wc, int fr, int fq) const {
        const int row0 = u.pm * BM + wr * 64 + fr, col0 = u.pn * BM + wc * 32 + 8 * fq;
#pragma unroll
        for (int ai = 0; ai < 2; ++ai)
#pragma unroll
            for (int m = 0; m < 4; ++m) { const int row = row0 + ai * HALF + m * 16;
#pragma unroll
                for (int bj = 0; bj < 2; ++bj) { const u32x4 g = *(const u32x4*)(G + (size_t)row * 8192 + col0 + bj * HALF); float* tp = T + (size_t)row * 4096 + col0 + bj * HALF;
                    *(f32x4*)tp = acc[ai][bj][m][0] * (f32x4){bf_lo(g.x), bf_hi(g.x), bf_lo(g.y), bf_hi(g.y)};
                    *(f32x4*)(tp + 4) = acc[ai][bj][m][1] * (f32x4){bf_lo(g.z), bf_hi(g.z), bf_lo(g.w), bf_hi(g.w)}; } }
    }
};
struct EpiMix {
    static constexpr bool PERM = true;
    const float* T; const bf16_t* G; bf16_t* O;
    __device__ __forceinline__ void operator()(const f32x4 (&acc)[2][2][4][2], const Unit& u, int wr, int wc, int fr, int fq) const {
        const int row0 = u.pm * BM + wr * 64 + fr, col0 = u.pn * BM + wc * 32 + 8 * fq;
#pragma unroll
        for (int ai = 0; ai < 2; ++ai)
#pragma unroll
            for (int m = 0; m < 4; ++m) { const int row = row0 + ai * HALF + m * 16;
#pragma unroll
                for (int bj = 0; bj < 2; ++bj) { const u32x4 g = *(const u32x4*)(G + (size_t)row * 8192 + col0 + bj * HALF); const float* tp = T + (size_t)row * 4096 + col0 + bj * HALF;
                    const f32x4 t0 = *(const f32x4*)tp, t1 = *(const f32x4*)(tp + 4);
                    const f32x4 v0 = t0 + acc[ai][bj][m][0] * (f32x4){bf_lo(g.x), bf_hi(g.x), bf_lo(g.y), bf_hi(g.y)};
                    const f32x4 v1 = t1 + acc[ai][bj][m][1] * (f32x4){bf_lo(g.z), bf_hi(g.z), bf_lo(g.w), bf_hi(g.w)};
                    *(u32x4*)(O + (size_t)row * 4096 + col0 + bj * HALF) = pack8(v0, v1); } }
    }
};
struct EpiGateI8 {
    static constexpr bool PERM = true;
    bf16_t *UV, *G; const float *hs, *cs;
    template <int ACT> __device__ __forceinline__ void put(const f32x4 (&acc)[2][2][4][2], bf16_t* dst, int ld, int row0, int col0, int sc0) const {
        f32x4 cv[2][2];
#pragma unroll
        for (int bj = 0; bj < 2; ++bj)
#pragma unroll
            for (int n = 0; n < 2; ++n) cv[bj][n] = *(const f32x4*)(cs + sc0 + bj * HALF + n * 4);
#pragma unroll
        for (int ai = 0; ai < 2; ++ai)
#pragma unroll
            for (int m = 0; m < 4; ++m) { const int row = row0 + ai * HALF + m * 16; const float h = hs[row];
#pragma unroll
                for (int bj = 0; bj < 2; ++bj) {
                    const f32x4 v0 = __builtin_convertvector(__builtin_bit_cast(i32x4, acc[ai][bj][m][0]), f32x4) * (cv[bj][0] * h);
                    const f32x4 v1 = __builtin_convertvector(__builtin_bit_cast(i32x4, acc[ai][bj][m][1]), f32x4) * (cv[bj][1] * h);
                    *(u32x4*)(dst + (size_t)row * ld + col0 + bj * HALF) = pack8(act4<ACT>(v0), act4<ACT>(v1)); } }
    }
    __device__ __forceinline__ void operator()(const f32x4 (&acc)[2][2][4][2], const Unit& u, int wr, int wc, int fr, int fq) const {
        const int row0 = u.pm * BM + wr * 64 + fr, cw = wc * 32 + 8 * fq;
        if (u.pn < UV8 / 256) put<1>(acc, UV, 4096, row0, u.pn * BM + cw, u.pn * BM + cw);
        else put<2>(acc, G, 8192, row0, (u.pn - UV8 / 256) * BM + cw, u.pn * BM + cw);
    }
};
template <int ACT> struct EpiActI8 {
    static constexpr bool PERM = true;
    bf16_t* O; int ld; const float *hs, *cs;
    __device__ __forceinline__ void operator()(const f32x4 (&acc)[2][2][4][2], const Unit& u, int wr, int wc, int fr, int fq) const {
        const int row0 = u.pm * BM + wr * 64 + fr, col0 = u.pn * BM + wc * 32 + 8 * fq;
        f32x4 cv[2][2];
#pragma unroll
        for (int bj = 0; bj < 2; ++bj)
#pragma unroll
            for (int n = 0; n < 2; ++n) cv[bj][n] = *(const f32x4*)(cs + col0 + bj * HALF + n * 4);
#pragma unroll
        for (int ai = 0; ai < 2; ++ai)
#pragma unroll
            for (int m = 0; m < 4; ++m) { const int row = row0 + ai * HALF + m * 16; const float h = hs[row];
#pragma unroll
                for (int bj = 0; bj < 2; ++bj) {
                    const f32x4 v0 = __builtin_convertvector(__builtin_bit_cast(i32x4, acc[ai][bj][m][0]), f32x4) * (cv[bj][0] * h);
                    const f32x4 v1 = __builtin_convertvector(__builtin_bit_cast(i32x4, acc[ai][bj][m][1]), f32x4) * (cv[bj][1] * h);
                    *(u32x4*)(O + (size_t)row * ld + col0 + bj * HALF) = pack8(act4<ACT>(v0), act4<ACT>(v1)); } }
    }
};
struct EpiMixFused {
    static constexpr bool PERM = true, HAS_MID = true;
    const bf16_t* G; bf16_t* O; int tmid;
    __device__ __forceinline__ void mid(f32x4 (&acc)[2][2][4][2], const Unit& u, int wr, int wc, int fr, int fq) const {
        const char* gbase = (const char*)(G + (size_t)(u.pm * BM) * 8192 + u.pn * BM);
        unsigned loff = (unsigned)((wr * 64 + fr) * 8192 + wc * 32 + 8 * fq) * 2u;
        asm volatile("" : "+s"(gbase), "+v"(loff));
#pragma unroll
        for (int ai = 0; ai < 2; ++ai)
#pragma unroll
            for (int m = 0; m < 4; ++m) {
#pragma unroll
                for (int bj = 0; bj < 2; ++bj) { const char* gp = gbase + (size_t)((ai * HALF + m * 16) * 8192 + bj * HALF) * 2;
                    const u32x4 ga = *(const u32x4*)(gp + loff), gb = *(const u32x4*)(gp + 8192 + loff);
                    f32x4 r0, r1;
                    r0[0] = bf_lo(ga.x) * __builtin_amdgcn_rcpf(fmaxf(bf_lo(gb.x), 1e-30f)); r0[1] = bf_hi(ga.x) * __builtin_amdgcn_rcpf(fmaxf(bf_hi(gb.x), 1e-30f));
                    r0[2] = bf_lo(ga.y) * __builtin_amdgcn_rcpf(fmaxf(bf_lo(gb.y), 1e-30f)); r0[3] = bf_hi(ga.y) * __builtin_amdgcn_rcpf(fmaxf(bf_hi(gb.y), 1e-30f));
                    r1[0] = bf_lo(ga.z) * __builtin_amdgcn_rcpf(fmaxf(bf_lo(gb.z), 1e-30f)); r1[1] = bf_hi(ga.z) * __builtin_amdgcn_rcpf(fmaxf(bf_hi(gb.z), 1e-30f));
                    r1[2] = bf_lo(ga.w) * __builtin_amdgcn_rcpf(fmaxf(bf_lo(gb.w), 1e-30f)); r1[3] = bf_hi(ga.w) * __builtin_amdgcn_rcpf(fmaxf(bf_hi(gb.w), 1e-30f));
                    acc[ai][bj][m][0] *= r0; acc[ai][bj][m][1] *= r1; }
                asm volatile("" : "+v"(acc[ai][0][m][0]), "+v"(acc[ai][0][m][1]), "+v"(acc[ai][1][m][0]), "+v"(acc[ai][1][m][1]) :: "memory"); }
    }
    __device__ __forceinline__ void operator()(const f32x4 (&acc)[2][2][4][2], const Unit& u, int wr, int wc, int fr, int fq) const {
        const int row0 = u.pm * BM + wr * 64 + fr, col0 = u.pn * BM + wc * 32 + 8 * fq;
#pragma unroll
        for (int ai = 0; ai < 2; ++ai)
#pragma unroll
            for (int m = 0; m < 4; ++m) { const int row = row0 + ai * HALF + m * 16;
#pragma unroll
                for (int bj = 0; bj < 2; ++bj) { const u32x4 g = *(const u32x4*)(G + (size_t)row * 8192 + 4096 + col0 + bj * HALF);
                    const f32x4 v0 = acc[ai][bj][m][0] * (f32x4){bf_lo(g.x), bf_hi(g.x), bf_lo(g.y), bf_hi(g.y)};
                    const f32x4 v1 = acc[ai][bj][m][1] * (f32x4){bf_lo(g.z), bf_hi(g.z), bf_lo(g.w), bf_hi(g.w)};
                    *(u32x4*)(O + (size_t)row * 4096 + col0 + bj * HALF) = pack8(v0, v1); } }
    }
};
struct EpiMixI8 {
    static constexpr bool PERM = true, HAS_MID = true;
    const bf16_t* G; bf16_t* O; int tmid; const float *sa, *sb, *cs;
    template <bool FIN> __device__ __forceinline__ void run(f32x4 (&acc)[2][2][4][2], const Unit& u, int wr, int wc, int fr, int fq) const {
        const char* gbase = (const char*)(G + (size_t)(u.pm * BM) * 8192 + u.pn * BM + (FIN ? 4096 : 0));
        char* obase = (char*)(O + (size_t)(u.pm * BM) * 4096 + u.pn * BM);
        const char* cbase = (const char*)(cs + u.pn * BM); const char* rbase = (const char*)((FIN ? sb : sa) + u.pm * BM);
        unsigned goff = (unsigned)((wr * 64 + fr) * 8192 + wc * 32 + 8 * fq) * 2u, ooff = (unsigned)((wr * 64 + fr) * 4096 + wc * 32 + 8 * fq) * 2u, coff = (unsigned)(wc * 32 + 8 * fq) * 4u, roff = (unsigned)(wr * 64 + fr) * 4u;
        asm volatile("" : "+s"(gbase), "+s"(obase), "+s"(cbase), "+s"(rbase), "+v"(goff), "+v"(ooff), "+v"(coff), "+v"(roff));
        f32x4 cv[2][2];
#pragma unroll
        for (int bj = 0; bj < 2; ++bj) { cv[bj][0] = *(const f32x4*)(cbase + coff + bj * HALF * 4); cv[bj][1] = *(const f32x4*)(cbase + coff + bj * HALF * 4 + 16); }
#pragma unroll
        for (int ai = 0; ai < 2; ++ai)
#pragma unroll
            for (int m = 0; m < 4; ++m) { const int rl = ai * HALF + m * 16; const float rs = *(const float*)(rbase + roff + rl * 4);
#pragma unroll
                for (int bj = 0; bj < 2; ++bj) {
                    const u32x4 g = *(const u32x4*)(gbase + goff + (size_t)(rl * 8192 + bj * HALF) * 2);
                    char* op = obase + ooff + (size_t)(rl * 4096 + bj * HALF) * 2;
                    f32x4 v0 = __builtin_convertvector(__builtin_bit_cast(i32x4, acc[ai][bj][m][0]), f32x4) * (cv[bj][0] * rs) * (f32x4){bf_lo(g.x), bf_hi(g.x), bf_lo(g.y), bf_hi(g.y)};
                    f32x4 v1 = __builtin_convertvector(__builtin_bit_cast(i32x4, acc[ai][bj][m][1]), f32x4) * (cv[bj][1] * rs) * (f32x4){bf_lo(g.z), bf_hi(g.z), bf_lo(g.w), bf_hi(g.w)};
                    if constexpr (FIN) { const u32x4 pk = *(const u32x4*)op;
                        v0 += (f32x4){bf_lo(pk.x), bf_hi(pk.x), bf_lo(pk.y), bf_hi(pk.y)}; v1 += (f32x4){bf_lo(pk.z), bf_hi(pk.z), bf_lo(pk.w), bf_hi(pk.w)}; }
                    *(u32x4*)op = pack8(v0, v1);
                    if constexpr (!FIN) { acc[ai][bj][m][0] = (f32x4){0.f, 0.f, 0.f, 0.f}; acc[ai][bj][m][1] = (f32x4){0.f, 0.f, 0.f, 0.f}; } }
                if constexpr (!FIN) asm volatile("" : "+v"(acc[ai][0][m][0]), "+v"(acc[ai][0][m][1]), "+v"(acc[ai][1][m][0]), "+v"(acc[ai][1][m][1]) :: "memory"); }
    }
    __device__ __forceinline__ void mid(f32x4 (&acc)[2][2][4][2], const Unit& u, int wr, int wc, int fr, int fq) const { run<false>(acc, u, wr, wc, fr, fq); }
    __device__ __forceinline__ void operator()(const f32x4 (&acc)[2][2][4][2], const Unit& u, int wr, int wc, int fr, int fq) const { run<true>(const_cast<f32x4 (&)[2][2][4][2]>(acc), u, wr, wc, fr, fq); }
};
struct EpiRes {
    static constexpr bool PERM = false;
    const float* base; float* out; const float* mod;
    __device__ __forceinline__ void operator()(const f32x4 (&acc)[2][2][4][2], const Unit& u, int wr, int wc, int fr, int fq) const {
        const int row0 = u.pm * BM + wr * 64 + fr, col0 = u.pn * BM + wc * 32 + 4 * fq;
        const float* mb = mod + (size_t)(u.pm >> 3) * 24576 + col0;
        f32x4 gv[2][2];
#pragma unroll
        for (int bj = 0; bj < 2; ++bj)
#pragma unroll
            for (int n = 0; n < 2; ++n) gv[bj][n] = *(const f32x4*)(mb + bj * HALF + n * 16);
#pragma unroll
        for (int ai = 0; ai < 2; ++ai)
#pragma unroll
            for (int m = 0; m < 4; ++m) { const size_t off = (size_t)(row0 + ai * HALF + m * 16) * 4096 + col0;
#pragma unroll
                for (int bj = 0; bj < 2; ++bj)
#pragma unroll
                    for (int n = 0; n < 2; ++n) { const f32x4 b = *(const f32x4*)(base + off + bj * HALF + n * 16); *(f32x4*)(out + off + bj * HALF + n * 16) = b + gv[bj][n] * acc[ai][bj][m][n]; } }
    }
};

template <class T, class = void> struct has_mid { static constexpr bool value = false; };
template <class T> struct has_mid<T, decltype((void)T::HAS_MID)> { static constexpr bool value = T::HAS_MID; };
struct EpiResI8 {
    static constexpr bool PERM = true;
    const float* base; float* out; const float* mod; const float *ms, *cs;
    __device__ __forceinline__ void operator()(const f32x4 (&acc)[2][2][4][2], const Unit& u, int wr, int wc, int fr, int fq) const {
        const int row0 = u.pm * BM + wr * 64 + fr, col0 = u.pn * BM + wc * 32 + 8 * fq;
        const float* mb = mod + (size_t)(u.pm >> 3) * 24576 + col0;
        f32x4 gv[2][2];
#pragma unroll
        for (int bj = 0; bj < 2; ++bj)
#pragma unroll
            for (int n = 0; n < 2; ++n) gv[bj][n] = *(const f32x4*)(mb + bj * HALF + n * 4) * *(const f32x4*)(cs + col0 + bj * HALF + n * 4);
#pragma unroll
        for (int ai = 0; ai < 2; ++ai)
#pragma unroll
            for (int m = 0; m < 4; ++m) { const int row = row0 + ai * HALF + m * 16; const size_t off = (size_t)row * 4096 + col0; const float rs = ms[row];
#pragma unroll
                for (int bj = 0; bj < 2; ++bj)
#pragma unroll
                    for (int n = 0; n < 2; ++n) { const f32x4 b = *(const f32x4*)(base + off + bj * HALF + n * 4);
                        *(f32x4*)(out + off + bj * HALF + n * 4) = b + (gv[bj][n] * rs) * __builtin_convertvector(__builtin_bit_cast(i32x4, acc[ai][bj][m][n]), f32x4); } }
    }
};

template <class Epi, class Sched, bool ALIGN_EPI = PG8_ALIGN, bool SP2 = PG8_SP2, bool I8 = false>
__device__ __forceinline__ void gemm_phase(PG8_LAS unsigned char* lds, const Gemm g, const Sched& S, const Epi& E, const int wid) {
    const int lane = lane_id(), tid = wid * 64 + lane, wr = wid >> 2, wc = wid & 3, fr = lane & 15, fq = lane >> 4;
    const int K = g.K, nt = K / BK;
    unsigned voffA[2], voffB[2];
#pragma unroll
    for (int i = 0; i < 2; ++i) { int R, C; stage_rc(tid * 16 + i * 8192, R, C); const int Rb = Epi::PERM ? ((R & ~31) + perm32(R & 31)) : R;
        voffA[i] = (unsigned)(R * g.lda + C) * 2u; voffB[i] = (unsigned)(Rb * g.ldb + C) * 2u; }
    const size_t kstep = (size_t)(BK * 2);
    const size_t hstepA = (size_t)HALF * g.lda * 2, hstepB = (size_t)HALF * g.ldb * 2;
    const size_t tstepA = 2 * hstepA, tstepB = 2 * hstepB;
    const unsigned ldsw = (unsigned)wid * 1024u;
    const int aoff = lds_byte(wr * 64 + fr, fq * 8), boff = lds_byte(wc * 32 + fr, fq * 8);
#define PG8_SA(b, h) (((b) * 2 + (h)) * HTB)
#define PG8_SB(b, h) ((4 + (b) * 2 + (h)) * HTB)
#define PG8_STAGE(bufoff, gbase, voff) do { _Pragma("unroll") for (int _i = 0; _i < 2; ++_i) \
        __builtin_amdgcn_global_load_lds((const unsigned*)((const char*)(gbase) + (voff)[_i]), (PG8_LAS unsigned*)(lds + (bufoff) + ldsw + _i * 8192), 16, 0, 0); } while (0)
#define PG8_LDA(dst, b, h) do { _Pragma("unroll") for (int m = 0; m < 4; ++m) _Pragma("unroll") for (int k = 0; k < 2; ++k) dst[m][k] = *(const PG8_LAS bf16x8*)(lds + PG8_SA(b, h) + aoff + m * 2048 + k * 1024); } while (0)
#define PG8_LDB(dst, b, h) do { _Pragma("unroll") for (int n = 0; n < 2; ++n) _Pragma("unroll") for (int k = 0; k < 2; ++k) dst[n][k] = *(const PG8_LAS bf16x8*)(lds + PG8_SB(b, h) + boff + n * 2048 + k * 1024); } while (0)
#define PG8_MMA(ai, bj, At, Bt) do { __builtin_amdgcn_s_setprio(1); _Pragma("unroll") for (int m = 0; m < 4; ++m) _Pragma("unroll") for (int n = 0; n < 2; ++n) _Pragma("unroll") for (int k = 0; k < 2; ++k) \
        { if constexpr (I8) acc[ai][bj][m][n] = __builtin_bit_cast(f32x4, __builtin_amdgcn_mfma_i32_16x16x64_i8(__builtin_bit_cast(i32x4, Bt[n][k]), __builtin_bit_cast(i32x4, At[m][k]), __builtin_bit_cast(i32x4, acc[ai][bj][m][n]), 0, 0, 0)); \
          else acc[ai][bj][m][n] = __builtin_amdgcn_mfma_f32_16x16x32_bf16(Bt[n][k], At[m][k], acc[ai][bj][m][n], 0, 0, 0); } __builtin_amdgcn_s_setprio(0); } while (0)
#define PG8_WAIT_V(n) asm volatile("s_waitcnt vmcnt(" #n ")" ::: "memory")
#define PG8_WAIT_L(n) asm volatile("s_waitcnt lgkmcnt(" #n ")" ::: "memory")
#define PG8_BAR __builtin_amdgcn_s_barrier()
#define PG8_SCHED __builtin_amdgcn_sched_barrier(0)
    Unit cur, nxt; int ui = 0;
    if (!S.next(0, cur)) return;
    f32x4 acc[2][2][4][2];
#pragma unroll
    for (int a = 0; a < 2; ++a)
#pragma unroll
        for (int b = 0; b < 2; ++b)
#pragma unroll
            for (int m = 0; m < 4; ++m)
#pragma unroll
                for (int n = 0; n < 2; ++n) acc[a][b][m][n] = (f32x4){0.f, 0.f, 0.f, 0.f};
    bf16x8 At[4][2], B0[2][2], B1[2][2];
    const char* cA = (const char*)g.A + (size_t)cur.pm * tstepA; const char* cB = (const char*)g.Bt + (size_t)cur.pn * tstepB;
    if constexpr (SP2) {
    PG8_STAGE(PG8_SB(0, 0), cB, voffB); PG8_STAGE(PG8_SB(0, 1), cB + hstepB, voffB); PG8_STAGE(PG8_SA(0, 0), cA, voffA); PG8_STAGE(PG8_SA(0, 1), cA + hstepA, voffA);
    if (wr == 1) PG8_BAR;
    PG8_WAIT_V(2); PG8_BAR;
    PG8_STAGE(PG8_SB(1, 0), cB + kstep, voffB); PG8_STAGE(PG8_SA(1, 0), cA + kstep, voffA); PG8_STAGE(PG8_SB(1, 1), cB + hstepB + kstep, voffB);
    PG8_WAIT_V(6); PG8_BAR;
    } else {
    PG8_STAGE(PG8_SB(0, 0), cB, voffB); PG8_STAGE(PG8_SA(0, 0), cA, voffA); PG8_STAGE(PG8_SB(0, 1), cB + hstepB, voffB); PG8_STAGE(PG8_SA(0, 1), cA + hstepA, voffA);
    if (wr == 1) PG8_BAR;
    PG8_WAIT_V(4); PG8_BAR;
    PG8_STAGE(PG8_SB(1, 0), cB + kstep, voffB); PG8_STAGE(PG8_SA(1, 0), cA + kstep, voffA); PG8_STAGE(PG8_SB(1, 1), cB + hstepB + kstep, voffB);
    PG8_WAIT_V(6); PG8_BAR;
    }
    for (;;) {
        const bool has_next = S.next(ui + 1, nxt);
        const char* nA = has_next ? (const char*)g.A + (size_t)nxt.pm * tstepA : cA; const char* nB = has_next ? (const char*)g.Bt + (size_t)nxt.pn * tstepB : cB;
        asm volatile(".p2align 6");
        for (int t = 0; t < nt; t += 2) {
            if constexpr (has_mid<Epi>::value) { if (t == E.tmid) E.mid(acc, cur, wr, wc, fr, fq); }
            const bool last = (t == nt - 2);
            const char* a1 = cA + (size_t)(t + 1) * kstep;
            const char* a2 = last ? nA : cA + (size_t)(t + 2) * kstep; const char* b2 = last ? nB : cB + (size_t)(t + 2) * kstep;
            const char* a3 = a2 + kstep; const char* b3 = b2 + kstep;
            if constexpr (SP2) {
            PG8_LDB(B0, 0, 0); PG8_LDB(B1, 0, 1); PG8_SCHED; PG8_LDA(At, 0, 0); PG8_STAGE(PG8_SA(1, 1), a1 + hstepA, voffA);
            PG8_WAIT_V(8); PG8_WAIT_L(0); PG8_BAR; PG8_MMA(0, 0, At, B0); PG8_MMA(0, 1, At, B1); PG8_BAR; PG8_SCHED;
            PG8_LDA(At, 0, 1); PG8_STAGE(PG8_SB(0, 0), b2, voffB); PG8_STAGE(PG8_SB(0, 1), b2 + hstepB, voffB); PG8_STAGE(PG8_SA(0, 0), a2, voffA);
            PG8_WAIT_V(8); PG8_WAIT_L(0); PG8_BAR; PG8_MMA(1, 0, At, B0); PG8_MMA(1, 1, At, B1); PG8_BAR; PG8_SCHED;
            PG8_LDB(B0, 1, 0); PG8_LDB(B1, 1, 1); PG8_SCHED; PG8_LDA(At, 1, 0); PG8_STAGE(PG8_SA(0, 1), a2 + hstepA, voffA);
            PG8_WAIT_V(8); PG8_WAIT_L(0); PG8_BAR; PG8_MMA(0, 0, At, B0); PG8_MMA(0, 1, At, B1); PG8_BAR; PG8_SCHED;
            PG8_LDA(At, 1, 1); PG8_STAGE(PG8_SB(1, 0), b3, voffB); PG8_STAGE(PG8_SB(1, 1), b3 + hstepB, voffB); PG8_STAGE(PG8_SA(1, 0), a3, voffA);
            PG8_WAIT_V(8); PG8_WAIT_L(0); PG8_BAR; PG8_MMA(1, 0, At, B0); PG8_MMA(1, 1, At, B1); PG8_BAR; PG8_SCHED;
            } else {
            PG8_LDB(B0, 0, 0); PG8_SCHED; PG8_LDA(At, 0, 0); PG8_STAGE(PG8_SA(1, 1), a1 + hstepA, voffA);
            PG8_WAIT_L(8); PG8_BAR; PG8_WAIT_L(0); PG8_MMA(0, 0, At, B0); PG8_BAR; PG8_SCHED;
            PG8_LDB(B1, 0, 1); PG8_STAGE(PG8_SB(0, 0), b2, voffB);
            PG8_BAR; PG8_WAIT_L(0); PG8_MMA(0, 1, At, B1); PG8_BAR;
            PG8_LDA(At, 0, 1); PG8_STAGE(PG8_SA(0, 0), a2, voffA);
            PG8_BAR; PG8_WAIT_L(0); PG8_MMA(1, 0, At, B0); PG8_BAR; PG8_SCHED;
            PG8_STAGE(PG8_SB(0, 1), b2 + hstepB, voffB);
            PG8_WAIT_V(6); PG8_BAR; PG8_MMA(1, 1, At, B1); PG8_BAR;
            PG8_LDB(B0, 1, 0); PG8_SCHED; PG8_LDA(At, 1, 0); PG8_STAGE(PG8_SA(0, 1), a2 + hstepA, voffA);
            PG8_WAIT_L(8); PG8_BAR; PG8_WAIT_L(0); PG8_MMA(0, 0, At, B0); PG8_BAR; PG8_SCHED;
            PG8_LDB(B1, 1, 1); PG8_STAGE(PG8_SB(1, 0), b3, voffB);
            PG8_BAR; PG8_WAIT_L(0); PG8_MMA(0, 1, At, B1); PG8_BAR;
            PG8_LDA(At, 1, 1); PG8_STAGE(PG8_SA(1, 0), a3, voffA);
            PG8_BAR; PG8_WAIT_L(0); PG8_MMA(1, 0, At, B0); PG8_BAR; PG8_SCHED;
            PG8_STAGE(PG8_SB(1, 1), b3 + hstepB, voffB);
            PG8_WAIT_V(6); PG8_BAR; PG8_MMA(1, 1, At, B1); PG8_BAR;
            }
        }
        if constexpr (ALIGN_EPI) { if (wr == 0) PG8_BAR; }
        E(acc, cur, wr, wc, fr, fq);
        if (!has_next) break;
#pragma unroll
        for (int a = 0; a < 2; ++a)
#pragma unroll
            for (int b = 0; b < 2; ++b)
#pragma unroll
                for (int m = 0; m < 4; ++m)
#pragma unroll
                    for (int n = 0; n < 2; ++n) acc[a][b][m][n] = (f32x4){0.f, 0.f, 0.f, 0.f};
        cur = nxt; cA = nA; cB = nB; ++ui;
        if constexpr (ALIGN_EPI) { if (wr == 1) PG8_BAR; }
    }
    PG8_WAIT_V(0);
    if constexpr (!ALIGN_EPI) { if (wr == 0) PG8_BAR; }
    PG8_BAR;
#undef PG8_SA
#undef PG8_SB
#undef PG8_STAGE
#undef PG8_LDA
#undef PG8_LDB
#undef PG8_MMA
#undef PG8_WAIT_V
#undef PG8_WAIT_L
#undef PG8_BAR
#undef PG8_SCHED
}
}

constexpr int NWAVES = 8;
constexpr int BATCH = 4, SEQ = 2048, DM = 4096, M = BATCH * SEQ;
constexpr int GMW = 2048, NH = 32, QKH = 192, VH = 128, QLORA = 1024, KVLORA = 512, DFF = 16384, NMODC = 6 * DM;
constexpr int IN_COLS = 13888, OFF_GATE = 5696, NPAD = 14080, NP_GATE = 5888;
constexpr float EPS = 1e-6f;
constexpr float QSCALE = 0.07216878364870322f * 1.4426950408889634f;
constexpr int KSPLIT = 32, KCH = DM / KSPLIT;

constexpr size_t MiB = 1u << 20;
constexpr size_t WS_CTL = 0, CTL_ZERO_BYTES = 64 * 1024;
constexpr size_t WS_MOD = 1 * MiB, WS_STATS = 2 * MiB, WS_ROPE = 3 * MiB, WS_MODP = 5 * MiB;
constexpr size_t WS_WIN = 20 * MiB, WS_WUQ = 130 * MiB, WS_WUKV = 142 * MiB, WS_WAB = 150 * MiB, WS_WOUT = 198 * MiB, WS_WFF1 = 230 * MiB, WS_WFF2 = 358 * MiB;
constexpr size_t WS_H = 486 * MiB, WS_UV = 550 * MiB, WS_QL = 614 * MiB, WS_KVL = 630 * MiB, WS_KPE = 638 * MiB, WS_GATES = 642 * MiB, WS_AO = 770 * MiB;
constexpr size_t WS_Q = 866 * MiB, WS_KN = 962 * MiB, WS_V = 1026 * MiB, WS_K = 1090 * MiB, WS_MIXED = 1186 * MiB, WS_END = 1250 * MiB;
constexpr int NQ8 = UV8 + 8192;
constexpr size_t WS_WG8 = WS_WIN + 46 * MiB, WS_H8 = UV8 ? WS_WIN : WS_WIN + 78 * MiB;
constexpr size_t WS_CMAXP = WS_KN + 54 * MiB  , WS_CS = WS_KN + 2 * MiB, WS_HS = WS_KN + 3 * MiB;
constexpr int FF8 = 16384;
constexpr size_t WS_CMAXF = WS_KN + 40 * MiB, WS_CSF = WS_KN + 46 * MiB;
constexpr size_t WS_MS = WS_KN + 4 * MiB, WS_CSO = WS_KN + 5 * MiB, WS_CMAXO = WS_KN + 6 * MiB, WS_M8 = WS_KN + 8 * MiB;
constexpr size_t WS_CMAXAB = WS_KN + 48 * MiB, WS_CSAB = WS_KN + 50 * MiB, WS_SA = WS_KN + 51 * MiB, WS_SB = WS_KN + 52 * MiB, WS_A8 = WS_Q;
constexpr size_t WS_T = WS_Q;
constexpr size_t WS_F1 = WS_UV;
static_assert(WS_T + (size_t)M * 4096 * 4 <= WS_V && WS_F1 + (size_t)M * DFF * 2 <= WS_Q, "overlays");
constexpr int CW_BAR = 4096;

constexpr int RING_BYTES = 131072, LDS_BYTES = 163840, LDSCTL_OFF = LDS_BYTES - 512, MISC_OFF = LDSCTL_OFF + 320;

#define GAS __attribute__((address_space(1)))
#define LAS __attribute__((address_space(3)))
typedef unsigned short bf16;
typedef unsigned v4u __attribute__((ext_vector_type(4)));
typedef unsigned v2u __attribute__((ext_vector_type(2)));
typedef float f32x4 __attribute__((ext_vector_type(4)));
typedef float f32x16 __attribute__((ext_vector_type(16)));
typedef short bf16x8 __attribute__((ext_vector_type(8)));
typedef short s16x4 __attribute__((ext_vector_type(4)));
typedef GAS unsigned gu32;
#define RLX_AGENT __ATOMIC_RELAXED, __HIP_MEMORY_SCOPE_AGENT
#define LDS_WAIT() asm volatile("s_waitcnt lgkmcnt(0)" ::: "memory")
#define VM_WAIT() asm volatile("s_waitcnt vmcnt(0)" ::: "memory")
__device__ __forceinline__ unsigned f2bf(float f) { unsigned u = __builtin_bit_cast(unsigned, f); return (u + 0x7fffu + ((u >> 16) & 1u)) >> 16; }
__device__ __forceinline__ unsigned pk2(float lo, float hi) { return f2bf(lo) | (f2bf(hi) << 16); }
__device__ __forceinline__ float bflo(unsigned w) { return __uint_as_float(w << 16); }
__device__ __forceinline__ float bfhi(unsigned w) { return __uint_as_float(w & 0xffff0000u); }
__device__ __forceinline__ float wave_sum(float v) {
#pragma unroll
    for (int o = 1; o < 64; o <<= 1) v += __shfl_xor(v, o);
    return v;
}

#define XB_TMO      128
#define XB_XCNT(j)  (256  + 64 * (j))
#define XB_XSUB(j)  (1280 + 64 * (j))
#define XB_XGEN(j)  (2304 + 64 * (j))
#define XB_TOP      3328
#define XB_TOPGEN   3392
#define XCD_BAR_WORDS 3456
#define XB_SPIN_CAP (1u << 18)
__device__ __forceinline__ unsigned xb_ld(unsigned* p)              { return __hip_atomic_load(p, __ATOMIC_RELAXED, __HIP_MEMORY_SCOPE_AGENT); }
__device__ __forceinline__ unsigned xb_add(unsigned* p, unsigned v) { return __hip_atomic_fetch_add(p, v, __ATOMIC_RELAXED, __HIP_MEMORY_SCOPE_AGENT); }
__device__ __forceinline__ unsigned xb_xcc_id() { return (unsigned)__builtin_amdgcn_s_getreg((3 << 11) | 20) & 0xFu; }
#define XB_SPIN(cond, bar) do { unsigned _sp = 0; while (cond) { __builtin_amdgcn_s_sleep(1); \
    if ((++_sp & 255u) == 0u) { if (xb_ld(&(bar)[XB_TMO])) break; if (_sp > XB_SPIN_CAP) { atomicAdd(&(bar)[XB_TMO], 1u); break; } } } } while (0)
struct XcdBarrier { unsigned* bar; unsigned x; volatile LAS unsigned* st; int wave; };
__device__ __forceinline__ XcdBarrier xcd_barrier_post(unsigned* bar, volatile LAS unsigned* st, int wave) {
    XcdBarrier b; b.bar = bar; b.x = xb_xcc_id(); b.st = st; b.wave = wave;
    if (wave == 0 && pg8::lane_id() == 0) (void)xb_add(&bar[XB_XCNT(b.x)], 1u);
    return b;
}
__device__ __forceinline__ void xcd_barrier_complete(unsigned* bar, unsigned x, unsigned& nloc, unsigned& nx) {
    const unsigned G = gridDim.x * gridDim.y * gridDim.z;
    unsigned sum, cnt, mine, sp = 0u;
    for (;;) {
        sum = 0u; cnt = 0u; mine = 0u;
#pragma unroll
        for (unsigned j = 0; j < 16; ++j) { const unsigned c = xb_ld(&bar[XB_XCNT(j)]); sum += c; cnt += (c > 0u) ? 1u : 0u; mine = (j == x) ? c : mine; }
        if (sum == G) break;
        __builtin_amdgcn_s_sleep(1);
        if ((++sp & 255u) == 0u) { if (xb_ld(&bar[XB_TMO])) break; if (sp > XB_SPIN_CAP) { atomicAdd(&bar[XB_TMO], 1u); break; } }
    }
    nloc = mine > 0u ? mine : 1u; nx = cnt > 0u ? cnt : 1u;
}
__device__ __forceinline__ void xcd_barrier(const XcdBarrier& b) {
    asm volatile("s_waitcnt vmcnt(0)" ::: "memory");
    __syncthreads();
    if (b.wave == 0 && pg8::lane_id() == 0) {
        unsigned* bar = b.bar;
        __builtin_amdgcn_s_waitcnt(0);
        unsigned nloc = b.st[0], nx = b.st[1];
        if (nloc == 0u) { xcd_barrier_complete(bar, b.x, nloc, nx); b.st[0] = nloc; b.st[1] = nx; }
        const unsigned old = xb_add(&bar[XB_XSUB(b.x)], 1u);
        const unsigned gen = old / nloc;
        if (old + 1u == (gen + 1u) * nloc) {
            __builtin_amdgcn_fence(__ATOMIC_RELEASE, "agent");
            asm volatile("s_waitcnt vmcnt(0)" ::: "memory");
            const unsigned og = xb_add(&bar[XB_TOP], 1u);
            const unsigned tg = og / nx;
            if (og + 1u == (tg + 1u) * nx) xb_add(&bar[XB_TOPGEN], 1u);
            else XB_SPIN(xb_ld(&bar[XB_TOPGEN]) == tg, bar);
            __builtin_amdgcn_fence(__ATOMIC_ACQUIRE, "agent");
            xb_add(&bar[XB_XGEN(b.x)], 1u);
            asm volatile("s_waitcnt vmcnt(0)" ::: "memory");
        } else {
            XB_SPIN(xb_ld(&bar[XB_XGEN(b.x)]) == gen, bar);
            __builtin_amdgcn_fence(__ATOMIC_ACQUIRE, "agent");
            asm volatile("s_waitcnt vmcnt(0)" ::: "memory");
        }
    }
    __syncthreads();
}

struct Args { const float* in[22]; float* out; unsigned char* ws; float inv_freq[32]; int ph_lo, ph_hi; };
__device__ __forceinline__ f32x4 had4(const f32x4 v) { const float a = v.x + v.y, b = v.x - v.y, c = v.z + v.w, d = v.z - v.w; return (f32x4){a + c, b + d, a - c, b - d}; }
template <int CTRL> __device__ __forceinline__ float dpp_f(const float v) { return __int_as_float(__builtin_amdgcn_mov_dpp(__float_as_int(v), CTRL, 0xf, 0xf, true)); }
__device__ __forceinline__ float had_x(const float v, const int m, const int lane) {
    float p;
    if (m == 1) p = dpp_f<0xB1>(v);
    else if (m == 2) p = dpp_f<0x4E>(v);
    else if (m == 4) { const float up = dpp_f<0x104>(v), dn = dpp_f<0x114>(v); p = (lane & 4) ? dn : up; }
    else { const float up = dpp_f<0x108>(v), dn = dpp_f<0x118>(v); p = (lane & 8) ? dn : up; }
    return __builtin_fmaf(v, (lane & m) ? -1.0f : 1.0f, p);
}
template <int N_> __device__ __forceinline__ void had_reg(float (&w)[N_]) {
#pragma unroll
    for (int b = 1; b < N_; b <<= 1)
#pragma unroll
        for (int i = 0; i < N_; ++i) if (!(i & b)) { const float a = w[i], c = w[i + b]; w[i] = a + c; w[i + b] = a - c; }
}
__device__ __forceinline__ float rot_colmax64(const float* wp, const size_t ld) {
    float w[64];
#pragma unroll
    for (int kk = 0; kk < 64; ++kk) w[kk] = wp[(size_t)kk * ld];
    had_reg<64>(w);
    float mx = 0.f;
#pragma unroll
    for (int kk = 0; kk < 64; ++kk) mx = fmaxf(mx, fabsf(w[kk]));
    return mx;
}
struct Frame {
    LAS unsigned char* lds; int wave, vcu, G;
};

__device__ __forceinline__ void p0_transpose_item(const float* W, int N, bf16* WT, int ldt, int row_add, const float* gain, LAS float* scr, int kb, int nb, int lane) {
    const int k0 = 64 * kb, n0 = 32 * nb;
    { const float* wp = W + (size_t)(k0 + (lane >> 5)) * N + n0 + (lane & 31);
      float w[32];
#pragma unroll
      for (int i = 0; i < 32; ++i) w[i] = wp[(size_t)(2 * i) * N];
      if (gain) {
#pragma unroll
          for (int i = 0; i < 32; ++i) w[i] *= gain[k0 + 2 * i + (lane >> 5)]; }
#pragma unroll
      for (int i = 0; i < 32; ++i) scr[(2 * i + (lane >> 5)) * 33 + (lane & 31)] = w[i]; }
    LDS_WAIT(); asm volatile("" ::: "memory");
    const int c = lane & 7;
#pragma unroll
    for (int j = 0; j < 4; ++j) { const int n = (lane >> 3) + 8 * j; const LAS float* s = scr + (8 * c) * 33 + n;
        v4u o; o.x = pk2(s[0 * 33], s[1 * 33]); o.y = pk2(s[2 * 33], s[3 * 33]); o.z = pk2(s[4 * 33], s[5 * 33]); o.w = pk2(s[6 * 33], s[7 * 33]);
        *(v4u*)(WT + (size_t)(row_add + n0 + n) * ldt + k0 + 8 * c) = o; }
    LDS_WAIT(); asm volatile("" ::: "memory");
}
__device__ __forceinline__ void quant_transpose_item(const float* W, int N, signed char* WQ, int ldq, const float* step, LAS float* scr, int kb, int nb, int lane) {
    const int k0 = 64 * kb, n0 = 32 * nb;
    { const float* wp = W + (size_t)(k0 + (lane >> 5)) * N + n0 + (lane & 31);
      float w[32];
#pragma unroll
      for (int i = 0; i < 32; ++i) w[i] = wp[(size_t)(2 * i) * N];
#pragma unroll
      for (int i = 0; i < 32; ++i) scr[(2 * i + (lane >> 5)) * 33 + (lane & 31)] = w[i]; }
    LDS_WAIT(); asm volatile("" ::: "memory");
    const int c = lane & 7;
#pragma unroll
    for (int j = 0; j < 4; ++j) { const int n = (lane >> 3) + 8 * j; const LAS float* sp = scr + (8 * c) * 33 + n;
        const float st = step[n0 + n], inv = st > 0.f ? 1.0f / st : 0.f;
        int q[8]; float wv[8];
#pragma unroll
        for (int e = 0; e < 8; ++e) wv[e] = sp[e * 33];
        had_reg<8>(wv);
#pragma unroll
        for (int e = 0; e < 8; ++e) { wv[e] = had_x(wv[e], 1, lane); wv[e] = had_x(wv[e], 2, lane); wv[e] = had_x(wv[e], 4, lane); }
#pragma unroll
        for (int e = 0; e < 8; ++e) q[e] = (int)__float_as_uint(__builtin_fmaf(wv[e], inv, 12582912.0f));
        { const unsigned a01 = __builtin_amdgcn_perm((unsigned)q[1], (unsigned)q[0], 0x0c0c0400u), a23 = __builtin_amdgcn_perm((unsigned)q[3], (unsigned)q[2], 0x0c0c0400u), a45 = __builtin_amdgcn_perm((unsigned)q[5], (unsigned)q[4], 0x0c0c0400u), a67 = __builtin_amdgcn_perm((unsigned)q[7], (unsigned)q[6], 0x0c0c0400u);
          *(v2u*)(WQ + (size_t)(n0 + n) * ldq + k0 + 8 * c) = (v2u){__builtin_amdgcn_perm(a23, a01, 0x05040100u), __builtin_amdgcn_perm(a67, a45, 0x05040100u)}; } }
    LDS_WAIT(); asm volatile("" ::: "memory");
}
__device__ __forceinline__ void sincos_acc(float ang, float& c, float& s) {
    const double x = (double)ang, k = __builtin_rint(x * 0.15915494309189535), r = (x - k * 6.283185307179586) - k * 2.4492935982947064e-16, r2 = r * r;
    double sp = 1.0 / 2.585201673888498e22, cp = 1.0 / 6.204484017332394e23;
    const double sf[11] = {1.0 / 5.109094217170944e19, 1.0 / 1.21645100408832e17, 1.0 / 3.55687428096e14, 1.0 / 1.307674368e12, 1.0 / 6.2270208e9, 1.0 / 3.99168e7, 1.0 / 362880.0, 1.0 / 5040.0, 1.0 / 120.0, 1.0 / 6.0, 1.0};
    const double cf[12] = {1.0 / 1.1240007277776077e21, 1.0 / 2.43290200817664e18, 1.0 / 6.402373705728e15, 1.0 / 2.0922789888e13, 1.0 / 8.71782912e10, 1.0 / 4.790016e8, 1.0 / 3628800.0, 1.0 / 40320.0, 1.0 / 720.0, 1.0 / 24.0, 1.0 / 2.0, 1.0};
#pragma unroll
    for (int i = 0; i < 11; ++i) sp = sf[i] - sp * r2;
#pragma unroll
    for (int i = 0; i < 12; ++i) cp = cf[i] - cp * r2;
    s = (float)(sp * r); c = (float)cp;
}

#define SBAR() __builtin_amdgcn_sched_barrier(0)
constexpr int SHM_V = 64 * 128 * 2;
constexpr int KPITCH = 400, SHM_K = 64 * KPITCH;
__device__ __forceinline__ int v_st(int k, int c) { const int kk = (k & ~0xC) | ((k & 4) << 1) | ((k & 8) >> 1); return ((kk >> 3) * 4 + (c >> 5)) * 512 + ((kk & 7) * 32 + (c & 31)) * 2; }
__device__ __forceinline__ int v_rd_base(int lane) { return ((lane & 3) << 3) | (((lane >> 2) & 3) << 6) | (((lane >> 4) & 1) << 5) | (((lane >> 5) & 1) << 8); }
constexpr int v_rd_off(int d0, int ks, int half) { return d0 * 512 + ks * 4096 + half * 2048; }
__device__ __forceinline__ int crow(int r, int hi) { return (r & 3) + 8 * (r >> 2) + 4 * hi; }
__device__ __forceinline__ unsigned cvtpk(float lo, float hi) { return pg8::cvt_pk_bf16(lo, hi); }
template <int VOFF>
__device__ __forceinline__ void pv_tile(f32x16* o, int vb0, bf16x8 pa0, bf16x8 pa1, bf16x8 pa2, bf16x8 pa3) {
#define TRRD(dst, off) asm volatile("ds_read_b64_tr_b16 %0, %1 offset:%2" : "=&v"(dst) : "v"(vb0), "i"(off) : "memory")
#define PV_D0(d0) do { s16x4 l0, l1, l2, l3, h0, h1, h2, h3; constexpr int b_ = VOFF + v_rd_off(d0, 0, 0); \
        TRRD(l0, b_); TRRD(h0, b_ + 2048); TRRD(l1, b_ + 4096); TRRD(h1, b_ + 6144); TRRD(l2, b_ + 8192); TRRD(h2, b_ + 10240); TRRD(l3, b_ + 12288); TRRD(h3, b_ + 14336); \
        asm volatile("s_waitcnt lgkmcnt(0)" ::: "memory"); SBAR(); \
        o[d0] = __builtin_amdgcn_mfma_f32_32x32x16_bf16(pa0, (bf16x8){l0[0], l0[1], l0[2], l0[3], h0[0], h0[1], h0[2], h0[3]}, o[d0], 0, 0, 0); \
        o[d0] = __builtin_amdgcn_mfma_f32_32x32x16_bf16(pa1, (bf16x8){l1[0], l1[1], l1[2], l1[3], h1[0], h1[1], h1[2], h1[3]}, o[d0], 0, 0, 0); \
        o[d0] = __builtin_amdgcn_mfma_f32_32x32x16_bf16(pa2, (bf16x8){l2[0], l2[1], l2[2], l2[3], h2[0], h2[1], h2[2], h2[3]}, o[d0], 0, 0, 0); \
        o[d0] = __builtin_amdgcn_mfma_f32_32x32x16_bf16(pa3, (bf16x8){l3[0], l3[1], l3[2], l3[3], h3[0], h3[1], h3[2], h3[3]}, o[d0], 0, 0, 0); } while (0)
    PV_D0(0); PV_D0(1); PV_D0(2); PV_D0(3);
#undef PV_D0
#undef TRRD
}

struct BgState { int cur, next, end, stride; };
struct BgSrc { unsigned char* ws; };
constexpr int BG_C0 = 32 * 128, BG_C1 = 64 * 128, BG_C2 = 64 * 128, BG_C3 = 64 * 512, BG_C4 = 256 * 128, BG_ND = BG_C0 + BG_C1 + BG_C2 + BG_C3 + BG_C4;
constexpr size_t WS_BGTAB = 512 * 1024;
__device__ __forceinline__ void bg_find(const BgSrc S_, int d, const float*& W, bf16*& WT, int& N, int& ldt, int& kb, int& nb, int& mi) {
    unsigned char* ws = S_.ws;
    int r = d, i = 0;
    if (r >= BG_C0) { r -= BG_C0; i = 1; if (r >= BG_C1) { r -= BG_C1; i = 2; if (r >= BG_C2) { r -= BG_C2; i = 3; if (r >= BG_C3) { r -= BG_C3; i = 4; } } } }
    { typedef const float* __attribute__((address_space(4))) * kptr_t;
      const int k = (i < 3) ? 16 + i : 17 + i;
      W = ((kptr_t)__builtin_amdgcn_kernarg_segment_ptr())[k]; }
    const size_t woff = (i == 0) ? WS_WAB : (i == 1) ? WS_WAB + 2048   : (i == 2) ? WS_WOUT : (i == 3) ? WS_WFF1 : WS_WFF2;
    WT = (bf16*)(ws + woff);
    N = (i == 3) ? DFF : DM; ldt = (i < 2) ? 6144 : (i == 4) ? DFF : DM; const int nblk = (i == 3) ? 512 : 128;
    kb = r / nblk; nb = r - kb * nblk; mi = i;
}
__device__ __forceinline__ void bg_issue(const BgSrc ws, int d, LAS unsigned char* buf, LAS unsigned char* sbuf, int lane) {
    const float* W; bf16* WT; int N, ldt, kb, nb, mi; bg_find(ws, d, W, WT, N, ldt, kb, nb, mi);
    const int kr = lane >> 3, c = lane & 7;
    const float* src = W + (size_t)(64 * kb + kr) * N + 32 * nb;
#pragma unroll
    for (int j = 0; j < 8; ++j)
        __builtin_amdgcn_global_load_lds((const unsigned*)(src + (size_t)(8 * j) * N + 4 * ((c ^ kr ^ j) & 7)), (LAS unsigned*)(buf + j * 1024), 16, 0, 0);
    if (mi <= 2 || (mi == 3 && nb < FF8 / 32)) {
        const float* st = (const float*)(ws.ws + (mi < 2 ? WS_CSAB : mi == 2 ? WS_CSO : WS_CSF)) + 32 * nb + lane;
        __builtin_amdgcn_global_load_lds((const unsigned*)st, (LAS unsigned*)sbuf, 4, 0, 0); }
}
__device__ __forceinline__ void bg_process(const BgSrc ws, int d, LAS unsigned char* buf, LAS unsigned char* sbuf, int lane) {
    const float* W; bf16* WT; int N, ldt, kb, nb, mi; bg_find(ws, d, W, WT, N, ldt, kb, nb, mi);
    const int q = lane & 7;
    if (mi <= 2 || (mi == 3 && nb < FF8 / 32)) {
        signed char* WQ = (signed char*)WT;
#pragma unroll
        for (int jj = 0; jj < 4; ++jj) { const int n = (lane >> 3) + 8 * jj; float v[8];
#pragma unroll
            for (int r = 0; r < 8; ++r) v[r] = *(const LAS float*)(buf + (((8 * q + r) * 8 + (((n >> 2) ^ r ^ q) & 7)) * 16 + (n & 3) * 4));
            { had_reg<8>(v);
#pragma unroll
                for (int r = 0; r < 8; ++r) { v[r] = had_x(v[r], 1, lane); v[r] = had_x(v[r], 2, lane); v[r] = had_x(v[r], 4, lane); } }
            const float st = *(const LAS float*)(sbuf + n * 4), inv = st > 0.f ? 1.0f / st : 0.f;
            unsigned qv[8];
#pragma unroll
            for (int r = 0; r < 8; ++r) qv[r] = __float_as_uint(__builtin_fmaf(v[r], inv, 12582912.0f));
            const unsigned a01 = __builtin_amdgcn_perm(qv[1], qv[0], 0x0c0c0400u), a23 = __builtin_amdgcn_perm(qv[3], qv[2], 0x0c0c0400u), a45 = __builtin_amdgcn_perm(qv[5], qv[4], 0x0c0c0400u), a67 = __builtin_amdgcn_perm(qv[7], qv[6], 0x0c0c0400u);
            *(v2u*)(WQ + (size_t)(32 * nb + n) * (mi < 2 ? 6144 : DM) + 64 * kb + 8 * q) = (v2u){__builtin_amdgcn_perm(a23, a01, 0x05040100u), __builtin_amdgcn_perm(a67, a45, 0x05040100u)}; }
        return; }
#pragma unroll
    for (int jj = 0; jj < 4; ++jj) { const int n = (lane >> 3) + 8 * jj; float v[8];
#pragma unroll
        for (int r = 0; r < 8; ++r) v[r] = *(const LAS float*)(buf + (((8 * q + r) * 8 + (((n >> 2) ^ r ^ q) & 7)) * 16 + (n & 3) * 4));
        *(v4u*)(WT + (size_t)(32 * nb + n) * ldt + 64 * kb + 8 * q) = (v4u){pg8::cvt_pk_bf16(v[0], v[1]), pg8::cvt_pk_bf16(v[2], v[3]), pg8::cvt_pk_bf16(v[4], v[5]), pg8::cvt_pk_bf16(v[6], v[7])}; }
}
__device__ __forceinline__ void bg_step(const BgSrc T, BgState& B, LAS unsigned char* buf, LAS unsigned char* sbuf, int lane) {
    asm volatile("" : "+v"(lane));
    if (B.cur >= 0) { VM_WAIT(); bg_process(T, B.cur, buf, sbuf, lane); B.cur = -1; }
    if (B.next < B.end) { LDS_WAIT(); bg_issue(T, B.next, buf, sbuf, lane); B.cur = B.next; B.next += B.stride; }
}

constexpr float ATT_THR = 11.5f;
constexpr int ATT_LDS_V = 0, ATT_LDS_K = 2 * SHM_V, ATT_LDS_WS = 2 * SHM_V + 2 * SHM_K;
__device__ __forceinline__ void attn_unit(int b, int h, int qb, const bf16* Q, const bf16* Kg, const bf16* Vg, bf16* AO, char* lds, const float* g_qn, const float* ROPE_C, const float* ROPE_S, const BgSrc BT, BgState& BS, LAS unsigned char* bgbuf, LAS unsigned char* bgsbuf, const int wid) {
    const int lane = pg8::lane_id(), tid = wid * 64 + lane, r32 = lane & 31, hi = lane >> 5;
    const int rowbase = b * SEQ, q0 = qb * 256, NT = (q0 + 256) / 64;
    char* V_lds = lds + ATT_LDS_V; char* K_lds = lds + ATT_LDS_K;
    float* ws = (float*)(lds + ATT_LDS_WS) + wid * 64; float* li_l = ws; float* al_l = ws + 32;
    const int kkey = tid >> 3, kpart = tid & 7;
    const char* Kbase = (const char*)(Kg + ((size_t)rowbase * NH + h) * QKH);
    unsigned koffb = (unsigned)(kkey * NH * QKH + kpart * 8) * 2u;
    const int kws = kkey * KPITCH + kpart * 16;
    const int sr = tid >> 4, sc = (tid & 15) * 8, vst0 = v_st(sr, sc), vst1 = v_st(32 + sr, sc);
    const char* Vbase = (const char*)(Vg + ((size_t)rowbase * NH + h) * VH);
    unsigned voffb = (unsigned)(sr * NH * VH + sc) * 2u;
    asm volatile("" : "+v"(koffb), "+v"(voffb));
    const int vb0 = (int)(uintptr_t)V_lds + v_rd_base(lane);
    const int qlo = q0 + wid * 32, qm = qlo + r32 - 4 * hi;
    bf16x8 qr[12];
    { const char* qbase = (const char*)(Q + ((size_t)(rowbase + qlo) * NH + h) * QKH); unsigned qoffb = (unsigned)(r32 * NH * QKH + hi * 8) * 2u; asm volatile("" : "+v"(qoffb));
#pragma unroll
      for (int d0 = 0; d0 < 12; ++d0) qr[d0] = *(const bf16x8*)(qbase + qoffb + d0 * 32); }
    { float ss = 0.f;
#pragma unroll
      for (int d0 = 0; d0 < 12; ++d0) { const v4u w = __builtin_bit_cast(v4u, qr[d0]);
#pragma unroll
          for (int e = 0; e < 4; ++e) { const float a = bflo(w[e]), b2 = bfhi(w[e]); ss += a * a + b2 * b2; } }
      { auto rr = __builtin_amdgcn_permlane32_swap(__float_as_uint(ss), __float_as_uint(ss), false, false); ss = __uint_as_float(rr[0]) + __uint_as_float(rr[1]); }
      const float rs = QSCALE / sqrtf(ss * (1.0f / 192.0f) + EPS);
      unsigned goff = (unsigned)hi * 32u, roff = (unsigned)(r32 * 32 + hi * 8) * 4u;
      asm volatile("" : "+v"(goff), "+v"(roff));
      const float* gq = (const float*)((const char*)g_qn + goff);
#pragma unroll
      for (int d0 = 0; d0 < 8; ++d0) { const v4u w = __builtin_bit_cast(v4u, qr[d0]); const f32x4 g0 = *(const f32x4*)(gq + d0 * 16), g1 = *(const f32x4*)(gq + d0 * 16 + 4);
          const v4u o = {pk2(bflo(w[0]) * rs * g0[0], bfhi(w[0]) * rs * g0[1]), pk2(bflo(w[1]) * rs * g0[2], bfhi(w[1]) * rs * g0[3]),
                         pk2(bflo(w[2]) * rs * g1[0], bfhi(w[2]) * rs * g1[1]), pk2(bflo(w[3]) * rs * g1[2], bfhi(w[3]) * rs * g1[3])};
          qr[d0] = __builtin_bit_cast(bf16x8, o); }
      const float* cs = (const float*)((const char*)(ROPE_C + (size_t)(rowbase + qlo) * 32) + roff); const float* sn = (const float*)((const char*)(ROPE_S + (size_t)(rowbase + qlo) * 32) + roff);
#pragma unroll
      for (int d0 = 8; d0 < 10; ++d0) { const v4u wa = __builtin_bit_cast(v4u, qr[d0]), wb = __builtin_bit_cast(v4u, qr[d0 + 2]);
          const f32x4 g0 = *(const f32x4*)(gq + d0 * 16), g1 = *(const f32x4*)(gq + d0 * 16 + 4), h0 = *(const f32x4*)(gq + d0 * 16 + 32), h1 = *(const f32x4*)(gq + d0 * 16 + 36);
          const f32x4 c0 = *(const f32x4*)(cs + (d0 - 8) * 16), c1 = *(const f32x4*)(cs + (d0 - 8) * 16 + 4), s0 = *(const f32x4*)(sn + (d0 - 8) * 16), s1 = *(const f32x4*)(sn + (d0 - 8) * 16 + 4);
          float a[8], bq[8];
#pragma unroll
          for (int e = 0; e < 4; ++e) { a[2 * e] = bflo(wa[e]) * rs; a[2 * e + 1] = bfhi(wa[e]) * rs; bq[2 * e] = bflo(wb[e]) * rs; bq[2 * e + 1] = bfhi(wb[e]) * rs; }
#pragma unroll
          for (int e = 0; e < 4; ++e) { a[e] *= g0[e]; a[4 + e] *= g1[e]; bq[e] *= h0[e]; bq[4 + e] *= h1[e]; }
#pragma unroll
          for (int e = 0; e < 8; ++e) { const float c_ = e < 4 ? c0[e] : c1[e - 4], s_ = e < 4 ? s0[e] : s1[e - 4]; const float x1 = a[e], x2 = bq[e]; a[e] = x1 * c_ - x2 * s_; bq[e] = x2 * c_ + x1 * s_; }
          const v4u oa = {pk2(a[0], a[1]), pk2(a[2], a[3]), pk2(a[4], a[5]), pk2(a[6], a[7])}, ob = {pk2(bq[0], bq[1]), pk2(bq[2], bq[3]), pk2(bq[4], bq[5]), pk2(bq[6], bq[7])};
          qr[d0] = __builtin_bit_cast(bf16x8, oa); qr[d0 + 2] = __builtin_bit_cast(bf16x8, ob); } }
    bf16x8 sk0, sk1, sk2, sv0, sv1;
#define A_SLOAD(t) do { const char* kp_ = Kbase + (size_t)(t) * (64 * NH * QKH * 2); sk0 = *(const bf16x8*)(kp_ + koffb); sk1 = *(const bf16x8*)(kp_ + koffb + 128); sk2 = *(const bf16x8*)(kp_ + koffb + 256); \
        const char* vp_ = Vbase + (size_t)(t) * (64 * NH * VH * 2); sv0 = *(const bf16x8*)(vp_ + voffb); sv1 = *(const bf16x8*)(vp_ + voffb + 32 * NH * VH * 2); } while (0)
#define A_SWRITE(bf) do { char* kd_ = K_lds + (bf) * SHM_K + kws; *(bf16x8*)kd_ = sk0; *(bf16x8*)(kd_ + 128) = sk1; *(bf16x8*)(kd_ + 256) = sk2; \
        *(bf16x8*)(V_lds + (bf) * SHM_V + vst0) = sv0; *(bf16x8*)(V_lds + (bf) * SHM_V + vst1) = sv1; } while (0)
    float m_reg = -1e30f, l_reg = 0.f; f32x16 o[4] = {};
    A_SLOAD(0); VM_WAIT(); A_SWRITE(0); LDS_WAIT(); __syncthreads();
    const char* kb0 = K_lds + r32 * KPITCH + hi * 16;
#define A_STEP(t, BF) do { \
        if ((t) + 1 < NT) A_SLOAD((t) + 1); \
        if ((t) * 64 <= qlo + 31) {   \
        f32x16 p0 = {}, p1 = {}; \
        _Pragma("unroll") for (int d0 = 0; d0 < 12; ++d0) { const char* a_ = kb0 + (BF) * SHM_K + d0 * 32; \
            const bf16x8 k0_ = *(const bf16x8*)a_; const bf16x8 k1_ = *(const bf16x8*)(a_ + 32 * KPITCH); \
            p0 = __builtin_amdgcn_mfma_f32_32x32x16_bf16(k0_, qr[d0], p0, 0, 0, 0); p1 = __builtin_amdgcn_mfma_f32_32x32x16_bf16(k1_, qr[d0], p1, 0, 0, 0); if (d0 % 2 == 1) SBAR(); } \
        { const int kbase_ = (t) * 64; if (kbase_ + 63 > qlo) { const int dq_ = qm - kbase_; const float NEG_ = -__builtin_inff(); \
            _Pragma("unroll") for (int r = 0; r < 16; ++r) { const int c_ = (r & 3) + 8 * (r >> 2); if (dq_ - c_ < 0) p0[r] = NEG_; if (dq_ - c_ - 32 < 0) p1[r] = NEG_; } } } \
        float pmax_ = p0[0]; _Pragma("unroll") for (int r = 1; r < 16; ++r) pmax_ = fmaxf(pmax_, p0[r]); _Pragma("unroll") for (int r = 0; r < 16; ++r) pmax_ = fmaxf(pmax_, p1[r]); \
        { auto rr_ = __builtin_amdgcn_permlane32_swap(__float_as_uint(pmax_), __float_as_uint(pmax_), false, false); pmax_ = fmaxf(__uint_as_float(rr_[0]), __uint_as_float(rr_[1])); } \
        float mn_, alpha_; \
        if (__all(pmax_ - m_reg <= ATT_THR)) { mn_ = m_reg; alpha_ = 1.f; } else { mn_ = fmaxf(m_reg, pmax_); alpha_ = __builtin_amdgcn_exp2f(m_reg - mn_); m_reg = mn_; } \
        _Pragma("unroll") for (int r = 0; r < 16; ++r) { p0[r] = __builtin_amdgcn_exp2f(p0[r] - mn_); p1[r] = __builtin_amdgcn_exp2f(p1[r] - mn_); } \
        float ps_ = 0.f; _Pragma("unroll") for (int r = 0; r < 16; ++r) ps_ += p0[r]; _Pragma("unroll") for (int r = 0; r < 16; ++r) ps_ += p1[r]; \
        { auto rr_ = __builtin_amdgcn_permlane32_swap(__float_as_uint(ps_), __float_as_uint(ps_), false, false); ps_ = __uint_as_float(rr_[0]) + __uint_as_float(rr_[1]); } \
        l_reg = l_reg * alpha_ + ps_; \
        bf16x8 pa0_, pa1_, pa2_, pa3_; \
        A_PK4(p0, 0, pa0_); A_PK4(p0, 8, pa1_); A_PK4(p1, 0, pa2_); A_PK4(p1, 8, pa3_); \
        if (__any(alpha_ < 1.f)) { if (hi == 0) al_l[r32] = alpha_; LDS_WAIT(); \
            _Pragma("unroll") for (int d_ = 0; d_ < 4; ++d_) _Pragma("unroll") for (int r = 0; r < 16; ++r) o[d_][r] *= al_l[crow(r, hi)]; } \
        SBAR(); pv_tile<(BF) * SHM_V>(o, vb0, pa0_, pa1_, pa2_, pa3_); } \
        if ((t) + 1 < NT) { VM_WAIT(); A_SWRITE(1 - (BF)); } \
        bg_step(BT, BS, bgbuf, bgsbuf, lane);   \
        LDS_WAIT(); __syncthreads(); } while (0)
#define A_PK4(P, B_, OUT) do { unsigned a0_ = cvtpk(P[B_ + 0], P[B_ + 1]), a1_ = cvtpk(P[B_ + 2], P[B_ + 3]), b0_ = cvtpk(P[B_ + 4], P[B_ + 5]), b1_ = cvtpk(P[B_ + 6], P[B_ + 7]); \
        auto r0_ = __builtin_amdgcn_permlane32_swap(a0_, b0_, false, false); auto r1_ = __builtin_amdgcn_permlane32_swap(a1_, b1_, false, false); \
        v4u w_ = {r0_[0], r1_[0], r0_[1], r1_[1]}; OUT = __builtin_bit_cast(bf16x8, w_); } while (0)
    asm volatile(".p2align 6\n\ts_nop 0\n\ts_nop 0\n\ts_nop 0\n\ts_nop 0\n\ts_nop 0\n\ts_nop 0\n\ts_nop 0\n\ts_nop 0\n\ts_nop 0\n\ts_nop 0\n\ts_nop 0\n\ts_nop 0\n\ts_nop 0\n\ts_nop 0");
    for (int t = 0; t < NT; t += 2) { A_STEP(t, 0); asm volatile(".p2align 6\n\ts_nop 0\n\ts_nop 0\n\ts_nop 0\n\ts_nop 0\n\ts_nop 0\n\ts_nop 0\n\ts_nop 0\n\ts_nop 0\n\ts_nop 0\n\ts_nop 0\n\ts_nop 0\n\ts_nop 0\n\ts_nop 0\n\ts_nop 0"); A_STEP(t + 1, 1); }
#undef A_STEP
#undef A_PK4
#undef A_SLOAD
#undef A_SWRITE
    if (hi == 0) li_l[r32] = l_reg; LDS_WAIT();
    char* Ow = (char*)(AO + (size_t)(rowbase + qlo) * 6144 + 2048 + h * VH);
    unsigned ooffb = (unsigned)(4 * hi * 6144 + r32) * 2u; asm volatile("" : "+v"(ooffb));
#pragma unroll
    for (int r = 0; r < 16; ++r) { const int orow = crow(r, hi); const float rl = __builtin_amdgcn_rcpf(li_l[orow]);
#pragma unroll
        for (int d0 = 0; d0 < 4; ++d0) { const float v = o[d0][r] * rl; const float vn = __shfl_xor(v, 1);
            if ((r32 & 1) == 0) *(unsigned*)(Ow + ooffb + (((r & 3) + 8 * (r >> 2)) * 6144 + d0 * 32) * 2) = cvtpk(v, vn); } }
    LDS_WAIT(); __syncthreads();
}

__device__ __forceinline__ void gmlp_unit(int b, int n, int g, const bf16* UV, const float* rv, const float* w_s, const float* b_s, const float* g_v, bf16* AO, char* lds, const int wid) {
    const int lane = pg8::lane_id(), tid = wid * 64 + lane, r32 = lane & 31, hi = lane >> 5;
    const int wt = wid & 3, wh = wid >> 2, R0 = b * SEQ + n * 128, C0 = g * 256;
    { const int sr = tid >> 4, sc = (tid & 15) * 8, vst0 = v_st(sr, sc), vst1 = v_st(32 + sr, sc);
      bf16x8 tv[8];
#pragma unroll
      for (int sh = 0; sh < 2; ++sh)
#pragma unroll
          for (int ch = 0; ch < 2; ++ch) { const bf16* p = UV + (size_t)(R0 + sh * 64 + sr) * 4096 + 2048 + C0 + ch * 128 + sc;
              tv[(sh * 2 + ch) * 2] = *(const bf16x8*)p; tv[(sh * 2 + ch) * 2 + 1] = *(const bf16x8*)(p + (size_t)32 * 4096); }
#pragma unroll
      for (int i = 0; i < 4; ++i) { *(bf16x8*)(lds + i * SHM_V + vst0) = tv[2 * i]; *(bf16x8*)(lds + i * SHM_V + vst1) = tv[2 * i + 1]; } }
    LDS_WAIT(); __syncthreads();
    f32x16 o[4] = {};
    const int vb0 = (int)(uintptr_t)lds + wh * SHM_V + v_rd_base(lane);
    const int t = wt * 32 + r32;
    const float* wrow = w_s + ((size_t)g * 128 + t) * 128;
#define G_FRAG(ks, OUT) do { const int s0_ = (ks) * 16 + hi * 8; const f32x4 wa_ = *(const f32x4*)(wrow + s0_), wb_ = *(const f32x4*)(wrow + s0_ + 4); \
        const f32x4 ra_ = *(const f32x4*)(rv + R0 + s0_), rb_ = *(const f32x4*)(rv + R0 + s0_ + 4); float e_[8]; \
        _Pragma("unroll") for (int j = 0; j < 4; ++j) { e_[j] = (s0_ + j <= t) ? wa_[j] * ra_[j] : 0.f; e_[4 + j] = (s0_ + 4 + j <= t) ? wb_[j] * rb_[j] : 0.f; } \
        v4u w_ = {cvtpk(e_[0], e_[1]), cvtpk(e_[2], e_[3]), cvtpk(e_[4], e_[5]), cvtpk(e_[6], e_[7])}; OUT = __builtin_bit_cast(bf16x8, w_); } while (0)
    { bf16x8 pa0, pa1, pa2, pa3; G_FRAG(0, pa0); G_FRAG(1, pa1); G_FRAG(2, pa2); G_FRAG(3, pa3); SBAR(); pv_tile<0>(o, vb0, pa0, pa1, pa2, pa3); }
    if (wt >= 2) { bf16x8 pa0, pa1, pa2, pa3; G_FRAG(4, pa0); G_FRAG(5, pa1); G_FRAG(6, pa2); G_FRAG(7, pa3); SBAR(); pv_tile<2 * SHM_V>(o, vb0, pa0, pa1, pa2, pa3); }
#undef G_FRAG
#pragma unroll
    for (int d0 = 0; d0 < 4; ++d0) { const int c = C0 + wh * 128 + d0 * 32 + r32; const float gv = g_v[c];
#pragma unroll
        for (int r = 0; r < 16; ++r) { const int tr = wt * 32 + crow(r, hi); const size_t row = (size_t)(R0 + tr);
            const float u = __uint_as_float((unsigned)UV[row * 4096 + c] << 16);
            const float v = u * (gv * o[d0][r] + b_s[g * 128 + tr]); const float vn = __shfl_xor(v, 1);
            if ((r32 & 1) == 0) *(unsigned*)(AO + row * 6144 + c) = cvtpk(v, vn); } }
    LDS_WAIT(); __syncthreads();
}

__device__ __forceinline__ void head_norm_rope(v4u (&w)[12], int half, const float* gain, const float* cs, const float* sn, float scale) {
    float ss = 0.f;
#pragma unroll
    for (int j = 0; j < 12; ++j)
#pragma unroll
        for (int e = 0; e < 4; ++e) { const float a = bflo(w[j][e]), b2 = bfhi(w[j][e]); ss += a * a + b2 * b2; }
    ss += __shfl_xor(ss, 1);
    const float rs = scale / sqrtf(ss * (1.0f / 192.0f) + EPS);
    const float* gp = gain + half * 96;
#pragma unroll
    for (int j = 0; j < 4; ++j) {
        const f32x4 g0 = *(const f32x4*)(gp + 8 * j), g1 = *(const f32x4*)(gp + 8 * j + 4);
        w[j] = (v4u){pk2(bflo(w[j][0]) * rs * g0[0], bfhi(w[j][0]) * rs * g0[1]), pk2(bflo(w[j][1]) * rs * g0[2], bfhi(w[j][1]) * rs * g0[3]),
                     pk2(bflo(w[j][2]) * rs * g1[0], bfhi(w[j][2]) * rs * g1[1]), pk2(bflo(w[j][3]) * rs * g1[2], bfhi(w[j][3]) * rs * g1[3])};
    }
#pragma unroll
    for (int j = 4; j < 8; ++j) {
        float a[8], b[8];
        { const f32x4 g0 = *(const f32x4*)(gp + 8 * j), g1 = *(const f32x4*)(gp + 8 * j + 4), h0 = *(const f32x4*)(gp + 8 * j + 32), h1 = *(const f32x4*)(gp + 8 * j + 36);
#pragma unroll
          for (int e = 0; e < 4; ++e) { a[2 * e] = bflo(w[j][e]) * rs; a[2 * e + 1] = bfhi(w[j][e]) * rs; b[2 * e] = bflo(w[j + 4][e]) * rs; b[2 * e + 1] = bfhi(w[j + 4][e]) * rs; }
#pragma unroll
          for (int e = 0; e < 4; ++e) { a[e] *= g0[e]; a[4 + e] *= g1[e]; b[e] *= h0[e]; b[4 + e] *= h1[e]; } }
        if (half) {
            const f32x4 c0 = *(const f32x4*)(cs + 8 * (j - 4)), c1 = *(const f32x4*)(cs + 8 * (j - 4) + 4), s0 = *(const f32x4*)(sn + 8 * (j - 4)), s1 = *(const f32x4*)(sn + 8 * (j - 4) + 4);
#pragma unroll
            for (int e = 0; e < 8; ++e) { const float c_ = e < 4 ? c0[e] : c1[e - 4], s_ = e < 4 ? s0[e] : s1[e - 4]; const float x1 = a[e], x2 = b[e]; a[e] = x1 * c_ - x2 * s_; b[e] = x2 * c_ + x1 * s_; }
        }
        w[j] = (v4u){pk2(a[0], a[1]), pk2(a[2], a[3]), pk2(a[4], a[5]), pk2(a[6], a[7])};
        w[j + 4] = (v4u){pk2(b[0], b[1]), pk2(b[2], b[3]), pk2(b[4], b[5]), pk2(b[6], b[7])};
    }
}

__global__ void __launch_bounds__(NWAVES * 64, 2) hybrid_fwd(Args args) {
    extern __shared__ __attribute__((aligned(16))) unsigned char lds[];
    Frame F;
    F.lds = (LAS unsigned char*)lds;
    F.wave = __builtin_amdgcn_readfirstlane((int)threadIdx.x >> 6);
#define FTID (F.wave * 64 + pg8::lane_id())
    F.G = gridDim.x; { const int bx = blockIdx.x; F.vcu = (F.G % 8 == 0) ? (bx % 8) * (F.G / 8) + bx / 8 : bx; }
    unsigned char* ws = args.ws;
    gu32* ctl = (gu32*)(ws + WS_CTL);
    volatile LAS unsigned* MISC = (volatile LAS unsigned*)(F.lds + MISC_OFF);
    for (int u = FTID; u < (LDS_BYTES - LDSCTL_OFF) / 4; u += NWAVES * 64) ((LAS unsigned*)(F.lds + LDSCTL_OFF))[u] = 0u;
    __syncthreads();
    XcdBarrier bar; bar.bar = (unsigned*)(ctl + CW_BAR); bar.x = 0; bar.st = nullptr; bar.wave = F.wave;
    if (MK_N_LAUNCHES == 1) bar = xcd_barrier_post((unsigned*)(ctl + CW_BAR), MISC + 8, F.wave);
#define GRID_BAR() do { if (MK_N_LAUNCHES == 1) xcd_barrier(bar); } while (0)
    const int lo = args.ph_lo, hi_ph = args.ph_hi;
#define IN(k) (lo <= (k) && (k) < hi_ph && !(DIAG_STOP >= 0 && (k) > DIAG_STOP && (k) < 12))
#define BOTH(k) (IN(k) && IN((k) + 1))

    const float* x = args.in[0]; const float* cnd = args.in[1]; const int* positions = (const int*)args.in[2];
    const float* w_ada = args.in[3]; const float* b_ada = args.in[4]; const float* g_norm1 = args.in[5]; const float* w_in = args.in[6];
    const float* g_v = args.in[7]; const float* w_s = args.in[8]; const float* b_s = args.in[9]; const float* g_q_lat = args.in[10]; const float* g_kv_lat = args.in[11];
    const float* w_uq = args.in[12]; const float* w_ukv = args.in[13]; const float* g_qn = args.in[14]; const float* g_kn = args.in[15];
    const float* w_ba = args.in[16]; const float* w_bb = args.in[17]; const float* w_out = args.in[18]; const float* g_norm2 = args.in[19];
    const float* w_ff1 = args.in[20]; const float* w_ff2 = args.in[21];
    float* out = args.out;
    float* MOD = (float*)(ws + WS_MOD); float* RV = (float*)(ws + WS_STATS); float* RQ = RV + M; float* RKV = RQ + M;
    float* RPE = RKV + M; float* PER = (float*)(ws + WS_MODP);     float* ROPE_C = (float*)(ws + WS_ROPE); float* ROPE_S = ROPE_C + (size_t)M * 32; float* MODP = (float*)(ws + WS_MODP);
    bf16* WIN_T = (bf16*)(ws + WS_WIN); bf16* WUQ_T = (bf16*)(ws + WS_WUQ); bf16* WUKV_T = (bf16*)(ws + WS_WUKV); bf16* WAB_T = (bf16*)(ws + WS_WAB);
    bf16* WOUT_T = (bf16*)(ws + WS_WOUT); bf16* WFF1_T = (bf16*)(ws + WS_WFF1); bf16* WFF2_T = (bf16*)(ws + WS_WFF2);
    bf16* HB = (bf16*)(ws + WS_H); bf16* UV = (bf16*)(ws + WS_UV); bf16* QL = (bf16*)(ws + WS_QL); bf16* KVL = (bf16*)(ws + WS_KVL); bf16* KPE = (bf16*)(ws + WS_KPE);
    bf16* GATES = (bf16*)(ws + WS_GATES); bf16* AO = (bf16*)(ws + WS_AO); bf16* QB = (bf16*)(ws + WS_Q); bf16* KN = (bf16*)(ws + WS_KN); bf16* VB = (bf16*)(ws + WS_V);
    bf16* KB = (bf16*)(ws + WS_K); bf16* MIXED = (bf16*)(ws + WS_MIXED); float* TB = (float*)(ws + WS_T); bf16* F1 = (bf16*)(ws + WS_F1);
    signed char* WOUT8 = (signed char*)(ws + WS_WOUT); signed char* M8 = (signed char*)(ws + WS_M8); float* MSTEP = (float*)(ws + WS_MS); float* CSO = (float*)(ws + WS_CSO); float* CMAXO = (float*)(ws + WS_CMAXO);
    signed char* WG8 = (signed char*)(ws + WS_WG8); signed char* H8 = (signed char*)(ws + WS_H8); float* CMAXP = (float*)(ws + WS_CMAXP); float* CSTEP = (float*)(ws + WS_CS); float* HSTEP = (float*)(ws + WS_HS);
    float* CMAXAB = (float*)(ws + WS_CMAXAB); float* CSAB = (float*)(ws + WS_CSAB); float* SA = (float*)(ws + WS_SA); float* SB = (float*)(ws + WS_SB); signed char* A8 = (signed char*)(ws + WS_A8); signed char* WAB8 = (signed char*)(ws + WS_WAB);
    float* CMAXF = (float*)(ws + WS_CMAXF); float* CSF = (float*)(ws + WS_CSF); signed char* H28 = (signed char*)(ws + WS_H8); signed char* WFF18 = (signed char*)(ws + WS_WFF1);
    const int gw = F.vcu * NWAVES + F.wave, NGW = F.G * NWAVES;

    if (IN(0)) {
        const int ptid = FTID, plane = ptid & 63;
        LAS float* scr = (LAS float*)(F.lds + F.wave * 16384);
        for (int it = gw; it < KSPLIT * 96; it += NGW) {
            const int kc = it / 96, nc = it % 96, k0 = kc * KCH, n0 = nc * 256 + 4 * plane;
#pragma unroll
            for (int j = 0; j < 8; ++j) { const int idx = plane + 64 * j, bb = idx >> 7, kk = idx & 127; const float cv = cnd[bb * DM + k0 + kk]; scr[idx] = cv / (1.0f + __expf(-cv)); }
            LDS_WAIT(); asm volatile("" ::: "memory");
            f32x4 a0 = {0.f, 0.f, 0.f, 0.f}, a1 = a0, a2 = a0, a3 = a0;
            const float* wp = w_ada + (size_t)k0 * NMODC + n0;
#pragma unroll 8
            for (int kk = 0; kk < KCH; ++kk) { const f32x4 w = *(const f32x4*)(wp + (size_t)kk * NMODC);
                a0 += w * scr[kk]; a1 += w * scr[128 + kk]; a2 += w * scr[256 + kk]; a3 += w * scr[384 + kk]; }
            float* mp = MODP + (size_t)(kc * 4) * NMODC + n0;
            *(f32x4*)mp = a0; *(f32x4*)(mp + NMODC) = a1; *(f32x4*)(mp + 2 * NMODC) = a2; *(f32x4*)(mp + 3 * NMODC) = a3;
            LDS_WAIT(); asm volatile("" ::: "memory");
        }
        constexpr int NBF = UV8 ? 50 : 178, I_IN = 64 * NBF, I_UQ = 16 * 192, I_UKV = 8 * 256;
        constexpr int NITEMS = I_IN + I_UQ + I_UKV;
        for (int it = gw; it < NITEMS; it += NGW) {
            int r = it;
            if (r < I_IN) { const int kb = r / NBF, nb = (UV8 ? 128 : 0) + r % NBF; p0_transpose_item(w_in, IN_COLS, WIN_T, DM, 0, nullptr, scr, kb, nb, plane); continue; } r -= I_IN;
            if (r < I_UQ) { p0_transpose_item(w_uq, 6144, WUQ_T, QLORA, 0, g_q_lat, scr, r / 192, r % 192, plane); continue; } r -= I_UQ;
            p0_transpose_item(w_ukv, 8192, WUKV_T, KVLORA, 0, g_kv_lat, scr, r / 256, r % 256, plane);
        }
        for (int it = gw; it < 64 * 64; it += NGW) { const int kb = it >> 6, nc = it & 63;
            CMAXO[(size_t)kb * DM + nc * 64 + plane] = rot_colmax64(w_out + (size_t)(kb * 64) * DM + nc * 64 + plane, DM); }
        for (int it = gw; it < 64 * (FF8 / 64); it += NGW) { const int kb = it / (FF8 / 64), nc = it % (FF8 / 64);
            const float* wp = w_ff1 + (size_t)(kb * 64) * DFF + nc * 64 + plane;
            float w[64];
#pragma unroll
            for (int kk = 0; kk < 64; ++kk) w[kk] = wp[(size_t)kk * DFF];
            had_reg<64>(w);
            float mx = 0.f;
#pragma unroll
            for (int kk = 0; kk < 64; ++kk) mx = fmaxf(mx, fabsf(w[kk]));
            CMAXF[(size_t)kb * DFF + nc * 64 + plane] = mx; }
        for (int it = gw; it < 96 * 64; it += NGW) { const int kb = it >> 6, nc = it & 63;
            const float* wp = (kb < 32 ? w_ba + (size_t)(kb * 64) * DM : w_bb + (size_t)((kb - 32) * 64) * DM) + nc * 64 + plane;
            float w[64];
#pragma unroll
            for (int kk = 0; kk < 64; ++kk) w[kk] = wp[(size_t)kk * DM];
            had_reg<64>(w);
            float mx = 0.f;
#pragma unroll
            for (int kk = 0; kk < 64; ++kk) mx = fmaxf(mx, fabsf(w[kk]));
            CMAXAB[(size_t)kb * DM + nc * 64 + plane] = mx; }
        for (int i = gw * 64 + plane; i < 192 * 512; i += NGW * 64) *(v4u*)(WIN_T + (size_t)OFF_GATE * DM + (size_t)i * 8) = (v4u){0u, 0u, 0u, 0u};
        for (int i = gw * 64 + plane; i < M * 32; i += NGW * 64) { const int row = i >> 5, fi = i & 31; const float ang = (float)positions[row] * args.inv_freq[fi];
            float c_, s_; sincos_acc(ang, c_, s_); ROPE_C[i] = c_; ROPE_S[i] = s_; }
        for (int it = gw; it < 64 * (NQ8 / 64); it += NGW) { const int kb = it / (NQ8 / 64), nc = it % (NQ8 / 64), scol = nc * 64 + (nc >= UV8 / 64 ? OFF_GATE - UV8 : 0);
            CMAXP[(size_t)kb * NQ8 + nc * 64 + plane] = rot_colmax64(w_in + (size_t)(kb * 64) * IN_COLS + scol + plane, IN_COLS); }
        if (BOTH(0)) GRID_BAR();
    }

    if (IN(1)) {
        const int ptid = FTID, plane = ptid & 63;
        for (int wgi = blockIdx.x; wgi < M / 32; wgi += F.G) {
            if (ptid < 384) { const int idx = wgi * 384 + ptid, b2 = idx / NMODC, n = idx % NMODC; const float* mp = MODP + (size_t)b2 * NMODC + n;
                float pv_[KSPLIT];
#pragma unroll
                for (int kc = 0; kc < KSPLIT; ++kc) pv_[kc] = mp[(size_t)kc * 4 * NMODC];
                float s_ = b_ada[n];
#pragma unroll
                for (int kc = 0; kc < KSPLIT; ++kc) s_ += pv_[kc];
                MOD[idx] = s_; }
            if (ptid < NQ8 / 256) { const int n = wgi * (NQ8 / 256) + ptid; float mx = 0.f;
#pragma unroll
                for (int kc = 0; kc < 64; ++kc) mx = fmaxf(mx, CMAXP[(size_t)kc * NQ8 + n]);
                CSTEP[n] = mx * (1.0f / 127.0f); }
            if (ptid >= 64 && ptid < 80) { const int n = wgi * 16 + (ptid - 64); float mx = 0.f;
#pragma unroll
                for (int kc = 0; kc < 64; ++kc) mx = fmaxf(mx, CMAXO[(size_t)kc * DM + n]);
                CSO[n] = mx * (1.0f / 127.0f); }
            if (ptid >= 192 && ptid < 208) { const int n = wgi * 16 + (ptid - 192); float mx = 0.f;
#pragma unroll 8
                for (int kc = 0; kc < 96; ++kc) mx = fmaxf(mx, CMAXAB[(size_t)kc * DM + n]);
                CSAB[n] = mx * (1.0f / 127.0f); }
            if (ptid >= 128 && ptid < 192 && wgi * 64 < FF8) { const int n = wgi * 64 + (ptid - 128); float mx = 0.f;
#pragma unroll
                for (int kc = 0; kc < 64; ++kc) mx = fmaxf(mx, CMAXF[(size_t)kc * DFF + n]);
                CSF[n] = mx * (1.0f / 127.0f); }
        }
        GRID_BAR();
        { LAS float* scr = (LAS float*)(F.lds + F.wave * 16384);
          for (int it = gw; it < 64 * (NQ8 / 32); it += NGW) { const int kb = it / (NQ8 / 32), nb = it % (NQ8 / 32);
              quant_transpose_item(w_in + (nb >= UV8 / 32 ? OFF_GATE - UV8 : 0), IN_COLS, WG8, DM, CSTEP, scr, kb, nb, pg8::lane_id()); }
        }
        LDS_WAIT(); __syncthreads();
        LAS float* modl = (LAS float*)F.lds;
        for (int wgi = blockIdx.x; wgi < M / 32; wgi += F.G) {
            const int bb = wgi >> 6; const float* mb = MOD + (size_t)bb * NMODC;
#pragma unroll
            for (int j = 0; j < 2; ++j) { const int col = 4 * (ptid + 512 * j); const f32x4 g4 = *(const f32x4*)(g_norm1 + col), sh = *(const f32x4*)(mb + col), sc = *(const f32x4*)(mb + DM + col);
                *(LAS f32x4*)(modl + col) = g4 * (sc + 1.0f); *(LAS f32x4*)(modl + DM + col) = sh; }
            LDS_WAIT(); __syncthreads();
#pragma unroll 1
            for (int i = 0; i < 4; ++i) { const int row = wgi * 32 + F.wave * 4 + i; const int pl = pg8::lane_id();
                const f32x4* xr = (const f32x4*)(x + (size_t)row * DM) + pl;
                f32x4 v[16]; float ss = 0.f;
#pragma unroll
                for (int j = 0; j < 16; ++j) { v[j] = xr[64 * j]; ss += (v[j].x * v[j].x + v[j].y * v[j].y) + (v[j].z * v[j].z + v[j].w * v[j].w); }
                const float r = 1.0f / sqrtf(wave_sum(ss) * (1.0f / DM) + EPS);
                float hm = 0.f;
#pragma unroll
                for (int j = 0; j < 16; ++j) { const int col = 4 * (pl + 64 * j);
                    const f32x4 ga = *(const LAS f32x4*)(modl + col), sh = *(const LAS f32x4*)(modl + DM + col);
                    const f32x4 hv = v[j] * r * ga + sh; v[j] = hv;
                    *(v2u*)(HB + (size_t)row * DM + col) = (v2u){pk2(hv.x, hv.y), pk2(hv.z, hv.w)}; }
#pragma unroll
                for (int j = 0; j < 16; ++j) { f32x4 t = had4(v[j]);
#pragma unroll
                    for (int e = 0; e < 4; ++e) { float x_ = t[e]; x_ = had_x(x_, 1, pl); x_ = had_x(x_, 2, pl); x_ = had_x(x_, 4, pl); x_ = had_x(x_, 8, pl); t[e] = x_; }
                    v[j] = t; hm = fmaxf(fmaxf(hm, fmaxf(fabsf(t.x), fabsf(t.y))), fmaxf(fabsf(t.z), fabsf(t.w))); }
#pragma unroll
                for (int o_ = 1; o_ < 64; o_ <<= 1) hm = fmaxf(hm, __shfl_xor(hm, o_));
                const float inv = hm > 0.f ? 127.0f / hm : 0.f;
                if (pl == 0) HSTEP[row] = hm * (1.0f / (127.0f * 64.0f));
#pragma unroll
                for (int j = 0; j < 16; ++j) { const int col = 4 * (pl + 64 * j);
                    const unsigned q0 = __float_as_uint(__builtin_fmaf(v[j].x, inv, 12582912.0f)), q1 = __float_as_uint(__builtin_fmaf(v[j].y, inv, 12582912.0f)), q2 = __float_as_uint(__builtin_fmaf(v[j].z, inv, 12582912.0f)), q3 = __float_as_uint(__builtin_fmaf(v[j].w, inv, 12582912.0f));
                    *(unsigned*)(H8 + (size_t)row * DM + col) = __builtin_amdgcn_perm(__builtin_amdgcn_perm(q3, q2, 0x0c0c0400u), __builtin_amdgcn_perm(q1, q0, 0x0c0c0400u), 0x05040100u); } }
            LDS_WAIT(); __syncthreads();
        }
        if (BOTH(1)) GRID_BAR();
    }

    if (IN(2)) {
        const int ptid = FTID, plane = ptid & 63;
        { pg8::Gemm g{HB, WIN_T + (size_t)UV8 * DM, DM, DM, M, NP_GATE - UV8, DM}; pg8::StaticOrder S; S.init(M, NP_GATE - UV8, F.G, (int)blockIdx.x);
          pg8::EpiProj E{UV, QL, KVL, KPE, GATES, UV8 / 256};
          pg8::gemm_phase<pg8::EpiProj, pg8::StaticOrder>(F.lds, g, S, E, F.wave); }
        { pg8::Gemm g{(const bf16*)H8, (const bf16*)WG8, DM / 2, DM / 2, M, NQ8, DM / 2}; pg8::StaticOrder S; S.init(M, NQ8, F.G, (int)blockIdx.x);
          pg8::EpiGateI8 E{UV, GATES, HSTEP, CSTEP};
          pg8::gemm_phase<pg8::EpiGateI8, pg8::StaticOrder, PG8_ALIGN, PG8_SP2, true>(F.lds, g, S, E, F.wave); }
        if (BOTH(2)) GRID_BAR();
    }

    if (IN(3)) {
        const int ptid = FTID, plane = ptid & 63;
        for (int row = gw; row < M; row += NGW) {
            float sv = 0.f, sq = 0.f, sk = 0.f;
            const v4u* pv_ = (const v4u*)(UV + (size_t)row * 4096 + 2048) + plane;
#pragma unroll
            for (int j = 0; j < 4; ++j) { const v4u w = pv_[64 * j];
#pragma unroll
                for (int e = 0; e < 4; ++e) { const float a = bflo(w[e]), b2 = bfhi(w[e]); sv += a * a + b2 * b2; } }
            const v4u* pq_ = (const v4u*)(QL + (size_t)row * 1024) + plane;
#pragma unroll
            for (int j = 0; j < 2; ++j) { const v4u w = pq_[64 * j];
#pragma unroll
                for (int e = 0; e < 4; ++e) { const float a = bflo(w[e]), b2 = bfhi(w[e]); sq += a * a + b2 * b2; } }
            { const v4u w = *((const v4u*)(KVL + (size_t)row * 512) + plane);
#pragma unroll
                for (int e = 0; e < 4; ++e) { const float a = bflo(w[e]), b2 = bfhi(w[e]); sk += a * a + b2 * b2; } }
            sv = wave_sum(sv); sq = wave_sum(sq); sk = wave_sum(sk);
            float spe = 0.f;
            { const unsigned wv = (plane < 32) ? *((const unsigned*)(KPE + (size_t)row * 256) + plane) : 0u; const float e0 = bflo(wv), e1 = bfhi(wv); spe = e0 * e0 + e1 * e1;
              const int el = 2 * (plane & 31), i = el & 31; const float a0 = e0 * g_kn[128 + el], a1 = e1 * g_kn[129 + el];
              const float b0 = __shfl_xor(a0, 16), b1 = __shfl_xor(a1, 16);
              const float c0 = ROPE_C[(size_t)row * 32 + i], c1 = ROPE_C[(size_t)row * 32 + i + 1], s0 = ROPE_S[(size_t)row * 32 + i], s1 = ROPE_S[(size_t)row * 32 + i + 1];
              const float o0 = (el < 32) ? a0 * c0 - b0 * s0 : a0 * c0 + b0 * s0, o1 = (el < 32) ? a1 * c1 - b1 * s1 : a1 * c1 + b1 * s1;
              if (plane < 32) *(pg8::f32x2*)(PER + (size_t)row * 64 + el) = (pg8::f32x2){o0, o1}; }
            spe = wave_sum(spe);
            if (plane == 0) { RV[row] = 1.0f / sqrtf(sv * (1.0f / GMW) + EPS); RQ[row] = 1.0f / sqrtf(sq * (1.0f / QLORA) + EPS); RKV[row] = 1.0f / sqrtf(sk * (1.0f / KVLORA) + EPS); RPE[row] = spe; }
        }
        if (BOTH(3)) GRID_BAR();
    }

    if (IN(4)) {
        const int ptid = FTID, plane = ptid & 63;
        { pg8::Gemm g{QL, WUQ_T, QLORA, QLORA, M, NH * QKH, QLORA}; pg8::StaticOrder S; S.init(M, NH * QKH, F.G, (int)blockIdx.x);
          pg8::EpiRowScale<0> E{QB, NH * QKH, RQ};
          pg8::gemm_phase<pg8::EpiRowScale<0>, pg8::StaticOrder>(F.lds, g, S, E, F.wave); }
        { pg8::Gemm g{KVL, WUKV_T, KVLORA, KVLORA, M, NH * 256, KVLORA}; pg8::StaticOrder S; S.init(M, NH * 256, F.G, (int)blockIdx.x);
          pg8::EpiKV E{KB, VB, RKV, RPE, PER, g_kn, (PG8_LAS float*)(F.lds + RING_BYTES + 1024)};
          pg8::gemm_phase<pg8::EpiKV, pg8::StaticOrder>(F.lds, g, S, E, F.wave); }
        for (int u = F.vcu; u < BATCH * 16 * 8; u += F.G) { const int g_ = u & 7, n_ = (u >> 3) & 15, b_ = u >> 7;
            gmlp_unit(b_, n_, g_, UV, RV, w_s, b_s, g_v, AO, (char*)lds, F.wave); }
        if (BOTH(4)) GRID_BAR();
    }


    if (IN(6)) {
        const int ptid = FTID, plane = ptid & 63;
        const BgSrc BT{ws}; constexpr int ND = BG_ND;
        const int per = (ND + F.G - 1) / F.G;
        BgState BS; BS.cur = -1; BS.next = F.wave * F.G + F.vcu; BS.end = ND; BS.stride = NWAVES * F.G; (void)per;
        LAS unsigned char* bgbuf = F.lds + 86016 + F.wave * 8192; LAS unsigned char* bgsbuf = F.lds + 151552 + F.wave * 256;
        for (int it = F.vcu; it < BATCH * NH * 4; it += F.G) { const int bh = it >> 2, p = it & 3;
            attn_unit(bh >> 5, bh & 31, p, QB, KB, VB, AO, (char*)lds, g_qn, ROPE_C, ROPE_S, BT, BS, bgbuf, bgsbuf, F.wave);
            attn_unit(bh >> 5, bh & 31, 7 - p, QB, KB, VB, AO, (char*)lds, g_qn, ROPE_C, ROPE_S, BT, BS, bgbuf, bgsbuf, F.wave); }
        while (BS.cur >= 0 || BS.next < BS.end) bg_step(BT, BS, bgbuf, bgsbuf, plane);
        if (BOTH(6)) GRID_BAR();
    }

    if (IN(7)) {
        const int ptid = FTID, plane = ptid & 63;
        for (int row = gw; row < M; row += NGW) {
            const v4u* ar = (const v4u*)(AO + (size_t)row * 6144) + plane;
            v4u w[12];
#pragma unroll
            for (int j = 0; j < 12; ++j) w[j] = ar[64 * j];
            float ha = 0.f, hb = 0.f; float f[12][8];
#pragma unroll
            for (int j = 0; j < 12; ++j) {
#pragma unroll
                for (int e = 0; e < 4; ++e) { f[j][2 * e] = bflo(w[j][e]); f[j][2 * e + 1] = bfhi(w[j][e]); }
                had_reg<8>(f[j]);
#pragma unroll
                for (int e = 0; e < 8; ++e) { float x_ = f[j][e]; x_ = had_x(x_, 1, plane); x_ = had_x(x_, 2, plane); x_ = had_x(x_, 4, plane); f[j][e] = x_;
                    if (j < 4) ha = fmaxf(ha, fabsf(x_)); else hb = fmaxf(hb, fabsf(x_)); } }
#pragma unroll
            for (int o_ = 1; o_ < 64; o_ <<= 1) { ha = fmaxf(ha, __shfl_xor(ha, o_)); hb = fmaxf(hb, __shfl_xor(hb, o_)); }
            const float inva = ha > 0.f ? 127.0f / ha : 0.f, invb = hb > 0.f ? 127.0f / hb : 0.f;
            if (plane == 0) { SA[row] = ha * (1.0f / (127.0f * 64.0f)); SB[row] = hb * (1.0f / (127.0f * 64.0f)); }
#pragma unroll
            for (int j = 0; j < 12; ++j) { const float inv = j < 4 ? inva : invb; unsigned qv[8];
#pragma unroll
                for (int e = 0; e < 8; ++e) qv[e] = __float_as_uint(__builtin_fmaf(f[j][e], inv, 12582912.0f));
                const unsigned a01 = __builtin_amdgcn_perm(qv[1], qv[0], 0x0c0c0400u), a23 = __builtin_amdgcn_perm(qv[3], qv[2], 0x0c0c0400u), a45 = __builtin_amdgcn_perm(qv[5], qv[4], 0x0c0c0400u), a67 = __builtin_amdgcn_perm(qv[7], qv[6], 0x0c0c0400u);
                *(v2u*)(A8 + (size_t)row * 6144 + 8 * (plane + 64 * j)) = (v2u){__builtin_amdgcn_perm(a23, a01, 0x05040100u), __builtin_amdgcn_perm(a67, a45, 0x05040100u)}; }
        }
        GRID_BAR();
        pg8::Gemm g{(const bf16*)A8, (const bf16*)WAB8, 3072, 3072, M, DM, 3072}; pg8::StaticOrder S; S.init(M, DM, F.G, (int)blockIdx.x);
        pg8::EpiMixI8 E{GATES, MIXED, 1024 / 64, SA, SB, CSAB};
        pg8::gemm_phase<pg8::EpiMixI8, pg8::StaticOrder, PG8_ALIGN, PG8_SP2, true>(F.lds, g, S, E, F.wave);
        if (BOTH(7)) GRID_BAR();
    }

    if (IN(8)) {
        const int ptid = FTID, plane = ptid & 63;
        for (int row = gw; row < M; row += NGW) {
            const v4u* mr = (const v4u*)(MIXED + (size_t)row * DM) + plane;
            v4u w[8];
#pragma unroll
            for (int j = 0; j < 8; ++j) w[j] = mr[64 * j];
            float hm = 0.f; float f[8][8];
#pragma unroll
            for (int j = 0; j < 8; ++j) {
#pragma unroll
                for (int e = 0; e < 4; ++e) { f[j][2 * e] = bflo(w[j][e]); f[j][2 * e + 1] = bfhi(w[j][e]); }
                had_reg<8>(f[j]);
#pragma unroll
                for (int e = 0; e < 8; ++e) { float x_ = f[j][e]; x_ = had_x(x_, 1, plane); x_ = had_x(x_, 2, plane); x_ = had_x(x_, 4, plane); f[j][e] = x_; hm = fmaxf(hm, fabsf(x_)); } }
#pragma unroll
            for (int o_ = 1; o_ < 64; o_ <<= 1) hm = fmaxf(hm, __shfl_xor(hm, o_));
            const float inv = hm > 0.f ? 127.0f / hm : 0.f;
            if (plane == 0) MSTEP[row] = hm * (1.0f / (127.0f * 64.0f));
#pragma unroll
            for (int j = 0; j < 8; ++j) { unsigned qv[8];
#pragma unroll
                for (int e = 0; e < 8; ++e) qv[e] = __float_as_uint(__builtin_fmaf(f[j][e], inv, 12582912.0f));
                const unsigned a01 = __builtin_amdgcn_perm(qv[1], qv[0], 0x0c0c0400u), a23 = __builtin_amdgcn_perm(qv[3], qv[2], 0x0c0c0400u), a45 = __builtin_amdgcn_perm(qv[5], qv[4], 0x0c0c0400u), a67 = __builtin_amdgcn_perm(qv[7], qv[6], 0x0c0c0400u);
                *(v2u*)(M8 + (size_t)row * DM + 8 * (plane + 64 * j)) = (v2u){__builtin_amdgcn_perm(a23, a01, 0x05040100u), __builtin_amdgcn_perm(a67, a45, 0x05040100u)}; }
        }
        GRID_BAR();
        pg8::Gemm g{(const bf16*)M8, (const bf16*)WOUT8, DM / 2, DM / 2, M, DM, DM / 2}; pg8::StaticOrder S; S.init(M, DM, F.G, (int)blockIdx.x);
        pg8::EpiResI8 E{x, out, MOD + 2 * DM, MSTEP, CSO};
        pg8::gemm_phase<pg8::EpiResI8, pg8::StaticOrder, PG8_ALIGN, PG8_SP2, true>(F.lds, g, S, E, F.wave);
        if (BOTH(8)) GRID_BAR();
    }

    if (IN(9)) {
        const int ptid = FTID, plane = ptid & 63;
        LAS float* modl = (LAS float*)F.lds;
        for (int wgi = blockIdx.x; wgi < M / 32; wgi += F.G) {
            const int bb = wgi >> 6; const float* mb = MOD + (size_t)bb * NMODC;
#pragma unroll
            for (int j = 0; j < 2; ++j) { const int col = 4 * (ptid + 512 * j); const f32x4 g4 = *(const f32x4*)(g_norm2 + col), sh = *(const f32x4*)(mb + 3 * DM + col), sc = *(const f32x4*)(mb + 4 * DM + col);
                *(LAS f32x4*)(modl + col) = g4 * (sc + 1.0f); *(LAS f32x4*)(modl + DM + col) = sh; }
            LDS_WAIT(); __syncthreads();
#pragma unroll 1
            for (int i = 0; i < 4; ++i) { const int row = wgi * 32 + F.wave * 4 + i; const int pl = pg8::lane_id();
                const f32x4* xr = (const f32x4*)(out + (size_t)row * DM) + pl;
                f32x4 v[16]; float ss = 0.f;
#pragma unroll
                for (int j = 0; j < 16; ++j) { v[j] = xr[64 * j]; ss += (v[j].x * v[j].x + v[j].y * v[j].y) + (v[j].z * v[j].z + v[j].w * v[j].w); }
                const float r = 1.0f / sqrtf(wave_sum(ss) * (1.0f / DM) + EPS);
                float hm = 0.f;
#pragma unroll
                for (int j = 0; j < 16; ++j) { const int col = 4 * (pl + 64 * j);
                    const f32x4 ga = *(const LAS f32x4*)(modl + col), sh = *(const LAS f32x4*)(modl + DM + col);
                    const f32x4 hv = v[j] * r * ga + sh; v[j] = hv;
                    if constexpr (FF8 < DFF) *(v2u*)(HB + (size_t)row * DM + col) = (v2u){pk2(hv.x, hv.y), pk2(hv.z, hv.w)}; }
#pragma unroll
                for (int j = 0; j < 16; ++j) { f32x4 t = had4(v[j]);
#pragma unroll
                    for (int e = 0; e < 4; ++e) { float x_ = t[e]; x_ = had_x(x_, 1, pl); x_ = had_x(x_, 2, pl); x_ = had_x(x_, 4, pl); x_ = had_x(x_, 8, pl); t[e] = x_; }
                    v[j] = t; hm = fmaxf(fmaxf(hm, fmaxf(fabsf(t.x), fabsf(t.y))), fmaxf(fabsf(t.z), fabsf(t.w))); }
#pragma unroll
                for (int o_ = 1; o_ < 64; o_ <<= 1) hm = fmaxf(hm, __shfl_xor(hm, o_));
                const float inv = hm > 0.f ? 127.0f / hm : 0.f;
                if (pl == 0) HSTEP[row] = hm * (1.0f / (127.0f * 64.0f));
#pragma unroll
                for (int j = 0; j < 16; ++j) { const int col = 4 * (pl + 64 * j);
                    const unsigned q0 = __float_as_uint(__builtin_fmaf(v[j].x, inv, 12582912.0f)), q1 = __float_as_uint(__builtin_fmaf(v[j].y, inv, 12582912.0f)), q2 = __float_as_uint(__builtin_fmaf(v[j].z, inv, 12582912.0f)), q3 = __float_as_uint(__builtin_fmaf(v[j].w, inv, 12582912.0f));
                    *(unsigned*)(H28 + (size_t)row * DM + col) = __builtin_amdgcn_perm(__builtin_amdgcn_perm(q3, q2, 0x0c0c0400u), __builtin_amdgcn_perm(q1, q0, 0x0c0c0400u), 0x05040100u); } }
            LDS_WAIT(); __syncthreads();
        }
        if (BOTH(9)) GRID_BAR();
    }

    if (IN(10)) {
        const int ptid = FTID, plane = ptid & 63;
        { pg8::Gemm g{(const bf16*)H28, (const bf16*)WFF18, DM / 2, DM / 2, M, FF8, DM / 2}; pg8::StaticOrder S; S.init(M, FF8, F.G, (int)blockIdx.x);
          pg8::EpiActI8<3> E{F1, DFF, HSTEP, CSF};
          pg8::gemm_phase<pg8::EpiActI8<3>, pg8::StaticOrder, PG8_ALIGN, PG8_SP2, true>(F.lds, g, S, E, F.wave); }
        if constexpr (FF8 < DFF) { pg8::Gemm g{HB, WFF1_T + (size_t)FF8 * DM, DM, DM, M, DFF - FF8, DM}; pg8::StaticOrder S; S.init(M, DFF - FF8, F.G, (int)blockIdx.x);
          pg8::EpiRowScale<3> E{F1 + FF8, DFF, nullptr};
          pg8::gemm_phase<pg8::EpiRowScale<3>, pg8::StaticOrder>(F.lds, g, S, E, F.wave); }
        if (BOTH(10)) GRID_BAR();
    }

    if (IN(11)) {
        const int ptid = FTID, plane = ptid & 63;
        pg8::Gemm g{F1, WFF2_T, DFF, DFF, M, DM, DFF}; pg8::StaticOrder S; S.init(M, DM, F.G, (int)blockIdx.x);
        pg8::EpiRes E{out, out, MOD + 5 * DM};
        pg8::gemm_phase<pg8::EpiRes, pg8::StaticOrder>(F.lds, g, S, E, F.wave);
    }
    if (DIAG_STOP >= 0 && IN(12)) {
        const int ptid = FTID, plane = ptid & 63;
        GRID_BAR();
        for (int row = gw; row < M; row += NGW) {
#pragma unroll 1
            for (int c = plane; c < DM; c += 64) {
                float v;
                if (DIAG_STOP == 6) { v = (c < 2048) ? bflo(AO[(size_t)row * 6144 + c]) : bflo(AO[(size_t)row * 6144 + c]) + bflo(AO[(size_t)row * 6144 + c + 2048]); }
                else if (DIAG_STOP == 2) { v = bflo(GATES[(size_t)row * 8192 + c]) + bflo(GATES[(size_t)row * 8192 + 4096 + c]); }
                else if (DIAG_STOP == 5) { v = bflo(QB[(size_t)row * 6144 + c]) + bflo(KB[(size_t)row * 6144 + c]) + bflo(VB[(size_t)row * 4096 + c]) + ((c < 2048) ? (bflo(QB[(size_t)row * 6144 + 4096 + c]) + bflo(KB[(size_t)row * 6144 + 4096 + c])) : 0.f); }
                else if (DIAG_STOP == 0) { v = bflo(WIN_T[(size_t)(NP_GATE + row) * DM + c]); }
                else if (DIAG_STOP == 7) { v = bflo(MIXED[(size_t)row * 4096 + c]); }
                else if (DIAG_STOP == 8) { v = 4.0f * (bflo(MIXED[(size_t)row * DM + c]) - (float)M8[(size_t)row * DM + c] * MSTEP[row]); }
                else if (DIAG_STOP == 10) { v = bflo(F1[(size_t)row * DFF + c]) + bflo(F1[(size_t)row * DFF + 4096 + c]) + bflo(F1[(size_t)row * DFF + 8192 + c]) + bflo(F1[(size_t)row * DFF + 12288 + c]); }
                else { v = 4.0f * (bflo(HB[(size_t)row * 4096 + c]) - (float)H8[(size_t)row * DM + c] * HSTEP[row]); }
                out[(size_t)row * DM + c] = v;
            }
        }
    }
#undef IN
#undef BOTH
#undef GRID_BAR
}

extern "C" void kernel_launch(void* const* d_in, const int* in_sizes, int n_in, void* d_out, int out_size, void* d_ws, size_t ws_size, hipStream_t stream) {
    static int grid = 0;
    if (grid == 0) {
        if (n_in != 22 || in_sizes[0] != M * DM || out_size != M * DM || ws_size < WS_END) { fprintf(stderr, "kernel_launch: shape / workspace mismatch (n_in %d, ws %zu, need %zu)\n", n_in, ws_size, (size_t)WS_END); grid = -1; return; }
        int dev = 0, cus = 0, per_cu = 0;
        if (hipGetDevice(&dev) != hipSuccess || hipDeviceGetAttribute(&cus, hipDeviceAttributeMultiprocessorCount, dev) != hipSuccess) { grid = -1; return; }
        if (hipFuncSetAttribute((const void*)hybrid_fwd, hipFuncAttributeMaxDynamicSharedMemorySize, LDS_BYTES) != hipSuccess) { fprintf(stderr, "kernel_launch: hipFuncSetAttribute failed\n"); grid = -1; return; }
        if (hipOccupancyMaxActiveBlocksPerMultiprocessor(&per_cu, (const void*)hybrid_fwd, NWAVES * 64, LDS_BYTES) != hipSuccess || per_cu < 1)
            fprintf(stderr, "kernel_launch: note: occupancy query reports %d workgroups per CU\n", per_cu);
        (void)hipGetLastError();
        grid = cus;
    }
    if (grid < 0) return;
    if (hipMemsetAsync((char*)d_ws + WS_CTL, 0, CTL_ZERO_BYTES, stream) != hipSuccess) { fprintf(stderr, "kernel_launch: memset failed\n"); return; }
    Args a{};
    for (int i = 0; i < 22; ++i) a.in[i] = (const float*)d_in[i];
    a.out = (float*)d_out; a.ws = (unsigned char*)d_ws;
    for (int i = 0; i < 32; ++i) { const float e = (float)(2 * i) / 64.0f; const float p = powf(10000.0f, e); a.inv_freq[i] = 1.0f / p; }
    constexpr int NPH = (DIAG_STOP >= 0) ? 13 : 12;
    for (int li = 0; li < ((MK_N_LAUNCHES == 1) ? 1 : NPH); ++li) {
        a.ph_lo = (MK_N_LAUNCHES == 1) ? 0 : li; a.ph_hi = (MK_N_LAUNCHES == 1) ? NPH : li + 1;
        if (DIAG_STOP >= 0 && MK_N_LAUNCHES != 1 && li > DIAG_STOP && li < 12) continue;
        hipLaunchKernelGGL(hybrid_fwd, dim3(grid), dim3(NWAVES * 64), LDS_BYTES, stream, a);
        const hipError_t le = hipPeekAtLastError();
        if (le != hipSuccess) { fprintf(stderr, "kernel_launch: launch %d failed: %s\n", li, hipGetErrorName(le)); break; }
    }
    if (PROBE_REDO >= 0) { a.ph_lo = PROBE_REDO; a.ph_hi = PROBE_REDO + 1; hipLaunchKernelGGL(hybrid_fwd, dim3(grid), dim3(NWAVES * 64), LDS_BYTES, stream, a); }
}
```

```cpp
#include <hip/hip_runtime.h>
#include <cstdio>
#include <cstdint>
#include <cmath>

#ifndef DIAG_STOP
#define DIAG_STOP -1
#endif
#ifndef PG8_SP2
#define PG8_SP2 true
#endif
#ifndef PG8_ALIGN
#define PG8_ALIGN true
#endif
#ifndef PG8_WGM
#define PG8_WGM 8
#endif
#ifndef PROBE_REDO
#define PROBE_REDO -1
#endif
#ifndef MK_N_LAUNCHES
#define MK_N_LAUNCHES 1
#endif

constexpr int UV8 = 4096;
namespace pg8 {
__device__ __forceinline__ int lane_id() { int l; asm volatile("v_mbcnt_lo_u32_b32 %0, -1, 0\n\tv_mbcnt_hi_u32_b32 %0, -1, %0" : "=v"(l)); return l; }
#define PG8_LAS __attribute__((address_space(3)))
typedef unsigned short bf16_t;
typedef short bf16x8 __attribute__((ext_vector_type(8)));
typedef float f32x4 __attribute__((ext_vector_type(4)));
typedef float f32x2 __attribute__((ext_vector_type(2)));
typedef unsigned u32x4 __attribute__((ext_vector_type(4)));
typedef unsigned u32x2 __attribute__((ext_vector_type(2)));
typedef int i32x4 __attribute__((ext_vector_type(4)));
constexpr int BM = 256, BK = 64, HALF = 128, HTB = HALF * BK * 2, STAGE_BYTES = 8 * HTB, NXCD = 8, WGM = PG8_WGM;

__host__ __device__ __forceinline__ int lds_byte(int r, int c) { const int st = (r >> 4) * 2 + (c >> 5), rr = r & 15, cc = c & 31, ob = rr * 64 + cc * 2; return st * 1024 + (ob ^ (((ob >> 9) & 1) << 5)); }
__host__ __device__ __forceinline__ void stage_rc(int b, int& R, int& C) { const int st = b / 1024, sb = b % 1024, swz = sb ^ (((sb >> 9) & 1) << 5); R = (st >> 1) * 16 + swz / 64; C = (st & 1) * 32 + (swz % 64) / 2; }
__host__ __device__ __forceinline__ int perm32(int rho) { const int n = rho >> 4, i = rho & 15; return 8 * (i >> 2) + 4 * n + (i & 3); }

struct Unit { int pm, pn; };
struct Gemm { const bf16_t* A; const bf16_t* Bt; int lda, ldb; int M, N, K; };

struct StaticOrder {
    int nM, nN, nwg, G, c;
    __host__ __device__ void init(int M, int N, int G_, int c_) { nM = M / BM; nN = N / BM; nwg = nM * nN; G = G_; c = c_; }
    __host__ __device__ bool next(int i, Unit& u) const {
        const long L = (long)i * G + c; if (L >= nwg) return false;
        int wgid = (int)L; { const int q = nwg / NXCD, r = nwg % NXCD, xcd = wgid % NXCD, off = wgid / NXCD; wgid = (xcd < r ? xcd * (q + 1) : r * (q + 1) + (xcd - r) * q) + off; }
        const int nig = WGM * nN, gid = wgid / nig, fm = gid * WGM, gsz = (nM - fm) < WGM ? (nM - fm) : WGM;
        u.pm = fm + ((wgid % nig) % gsz); u.pn = (wgid % nig) / gsz; return true;
    }
};

typedef __bf16 bf16x2_t __attribute__((ext_vector_type(2)));
__device__ __forceinline__ unsigned cvt_pk_bf16(float lo, float hi) { f32x2 v = {lo, hi}; bf16x2_t b = __builtin_convertvector(v, bf16x2_t); return __builtin_bit_cast(unsigned, b); }
__device__ __forceinline__ u32x4 pack8(f32x4 a, f32x4 b) { u32x4 w; w.x = cvt_pk_bf16(a[0], a[1]); w.y = cvt_pk_bf16(a[2], a[3]); w.z = cvt_pk_bf16(b[0], b[1]); w.w = cvt_pk_bf16(b[2], b[3]); return w; }
__device__ __forceinline__ float bf_lo(unsigned w) { return __uint_as_float(w << 16); }
__device__ __forceinline__ float bf_hi(unsigned w) { return __uint_as_float(w & 0xffff0000u); }
__device__ __forceinline__ f32x2 gelu_pk(f32x2 v) {
    const f32x2 av = __builtin_elementwise_abs(v), d = av * 0.2316418882f + 1.0f;
    f32x2 t; t.x = __builtin_amdgcn_rcpf(d.x); t.y = __builtin_amdgcn_rcpf(d.y);
    f32x2 q = t * 0.5307027145f + (-0.7265760135f); q = q * t + 0.7107068705f; q = q * t + (-0.142248368f); q = q * t + 0.127414796f; q = q * t;
    const f32x2 s = (v * v) * (-0.72134752044f);
    f32x2 e; e.x = __builtin_amdgcn_exp2f(s.x); e.y = __builtin_amdgcn_exp2f(s.y);
    const f32x2 m = v * (q * e), r = v - m;
    f32x2 o; o.x = v.x < 0.f ? m.x : r.x; o.y = v.y < 0.f ? m.y : r.y; return o;
}
template <int ACT> __device__ __forceinline__ f32x4 act4(f32x4 v) {
    if constexpr (ACT == 1) { const f32x2 a = gelu_pk((f32x2){v[0], v[1]}), b = gelu_pk((f32x2){v[2], v[3]}); return (f32x4){a.x, a.y, b.x, b.y}; }
    else if constexpr (ACT == 2) { f32x4 o;
#pragma unroll
        for (int i = 0; i < 4; ++i) o[i] = __builtin_amdgcn_rcpf(1.0f + __builtin_amdgcn_exp2f(-1.4426950408889634f * v[i])); return o; }
    else if constexpr (ACT == 3) { f32x4 o;
#pragma unroll
        for (int i = 0; i < 4; ++i) { const float r = v[i] > 0.f ? v[i] : 0.f; o[i] = r * r; } return o; }
    else return v;
}

template <int ACT> __device__ __forceinline__ void store_tile_bf16(const f32x4 (&acc)[2][2][4][2], bf16_t* dst, int ld, int row0, int col0) {
#pragma unroll
    for (int ai = 0; ai < 2; ++ai)
#pragma unroll
        for (int m = 0; m < 4; ++m) { bf16_t* rowp = dst + (size_t)(row0 + ai * HALF + m * 16) * ld + col0;
#pragma unroll
            for (int bj = 0; bj < 2; ++bj) *(u32x4*)(rowp + bj * HALF) = pack8(act4<ACT>(acc[ai][bj][m][0]), act4<ACT>(acc[ai][bj][m][1])); }
}
struct EpiProj {
    static constexpr bool PERM = true;
    bf16_t *UV, *QL, *KVL, *KPE, *GATES; int pn0;
    __device__ __forceinline__ void operator()(const f32x4 (&acc)[2][2][4][2], const Unit& u, int wr, int wc, int fr, int fq) const {
        const int row0 = u.pm * BM + wr * 64 + fr, cw = wc * 32 + 8 * fq, pn = u.pn + pn0;
        if (pn < 16) store_tile_bf16<1>(acc, UV, 4096, row0, pn * BM + cw);
        else if (pn < 20) store_tile_bf16<0>(acc, QL, 1024, row0, (pn - 16) * BM + cw);
        else if (pn < 22) store_tile_bf16<0>(acc, KVL, 512, row0, (pn - 20) * BM + cw);
        else if (pn == 22) store_tile_bf16<0>(acc, KPE, 256, row0, cw);
        else store_tile_bf16<2>(acc, GATES, 8192, row0, (pn - 23) * BM + cw);
    }
};
template <int ACT> struct EpiRowScale {
    static constexpr bool PERM = true;
    bf16_t* O; int ld; const float* rs;
    __device__ __forceinline__ void operator()(const f32x4 (&acc)[2][2][4][2], const Unit& u, int wr, int wc, int fr, int fq) const {
        const int row0 = u.pm * BM + wr * 64 + fr, col0 = u.pn * BM + wc * 32 + 8 * fq;
#pragma unroll
        for (int ai = 0; ai < 2; ++ai)
#pragma unroll
            for (int m = 0; m < 4; ++m) { const int row = row0 + ai * HALF + m * 16; const float s = rs ? rs[row] : 1.0f; bf16_t* rowp = O + (size_t)row * ld + col0;
#pragma unroll
                for (int bj = 0; bj < 2; ++bj) *(u32x4*)(rowp + bj * HALF) = pack8(act4<ACT>(acc[ai][bj][m][0] * s), act4<ACT>(acc[ai][bj][m][1] * s)); }
    }
};
struct EpiKV {
    static constexpr bool PERM = true;
    bf16_t *K, *V; const float *rkv, *rpe, *per, *g_kn; PG8_LAS float* P;
    __device__ __forceinline__ void operator()(const f32x4 (&acc)[2][2][4][2], const Unit& u, int wr, int wc, int fr, int fq) const {
        const int rl0 = wr * 64 + fr, row0 = u.pm * BM + rl0, h = u.pn, cw = wc * 32 + 8 * fq;
#pragma unroll
        for (int ai = 0; ai < 2; ++ai)
#pragma unroll
            for (int m = 0; m < 4; ++m) { const f32x4 a = acc[ai][0][m][0], b = acc[ai][0][m][1];
                float s = (a[0] * a[0] + a[1] * a[1]) + (a[2] * a[2] + a[3] * a[3]) + (b[0] * b[0] + b[1] * b[1]) + (b[2] * b[2] + b[3] * b[3]);
                s += __shfl_xor(s, 16); s += __shfl_xor(s, 32);
                if (fq == 0) P[(ai * HALF + rl0 + m * 16) * 4 + wc] = s; }
        asm volatile("s_waitcnt lgkmcnt(0)" ::: "memory"); __builtin_amdgcn_s_barrier(); asm volatile("" ::: "memory");
        const f32x4 g0 = *(const f32x4*)(g_kn + cw), g1 = *(const f32x4*)(g_kn + cw + 4);
#pragma unroll
        for (int ai = 0; ai < 2; ++ai)
#pragma unroll
            for (int m = 0; m < 4; ++m) { const int rl = ai * HALF + rl0 + m * 16, row = u.pm * BM + rl; const float s = rkv[row];
                const f32x4 ps = *(const PG8_LAS f32x4*)(P + rl * 4);
                const float rk = s / sqrtf((((ps[0] + ps[1]) + (ps[2] + ps[3])) * s * s + rpe[row]) * (1.0f / 192.0f) + 1e-6f);
                *(u32x4*)(K + (size_t)row * 6144 + h * 192 + cw) = pack8(acc[ai][0][m][0] * rk * g0, acc[ai][0][m][1] * rk * g1);
                *(u32x4*)(V + (size_t)row * 4096 + h * 128 + cw) = pack8(acc[ai][1][m][0] * s, acc[ai][1][m][1] * s); }
        { const int tid = (wr * 4 + wc) * 64 + fq * 16 + fr, rl = tid >> 1, part = tid & 1, row = u.pm * BM + rl; const float s = rkv[row];
          const f32x4 ps = *(const PG8_LAS f32x4*)(P + rl * 4);
          const float rk = 1.0f / sqrtf((((ps[0] + ps[1]) + (ps[2] + ps[3])) * s * s + rpe[row]) * (1.0f / 192.0f) + 1e-6f);
          const float* pp = per + (size_t)row * 64 + part * 32; bf16_t* kp = K + (size_t)row * 6144 + h * 192 + 128 + part * 32;
#pragma unroll
          for (int j = 0; j < 4; ++j) { const f32x4 a = *(const f32x4*)(pp + 8 * j), b = *(const f32x4*)(pp + 8 * j + 4); *(u32x4*)(kp + 8 * j) = pack8(a * rk, b * rk); } }
    }
};
struct EpiGateF32 {
    static constexpr bool PERM = true;
    float* T; const bf16_t* G;
    __device__ __forceinline__ void operator()(const f32x4 (&acc)[2][2][4][2], const Unit& u, int wr, int wc, int fr, int fq) const {
        const int row0 = u.pm * BM + wr * 64 + fr, col0 = u.pn * BM + wc * 32 + 8 * fq;
#pragma unroll
        for (int ai = 0; ai < 2; ++ai)
#pragma unroll
            for (int m = 0; m < 4; ++m) { const int row = row0 + ai * HALF + m * 16;
#pragma unroll
                for (int bj = 0; bj < 2; ++bj) { const u32x4 g = *(const u32x4*)(G + (size_t)row * 8192 + col0 + bj * HALF); float* tp = T + (size_t)row * 4096 + col0 + bj * HALF;
                    *(f32x4*)tp = acc[ai][bj][m][0] * (f32x4){bf_lo(g.x), bf_hi(g.x), bf_lo(g.y), bf_hi(g.y)};
                    *(f32x4*)(tp + 4) = acc[ai][bj][m][1] * (f32x4){bf_lo(g.z), bf_hi(g.z), bf_lo(g.w), bf_hi(g.w)}; } }
    }
};
struct EpiMix {
    static constexpr bool PERM = true;
    const float* T; const bf16_t* G; bf16_t* O;
    __device__ __forceinline__ void operator()(const f32x4 (&acc)[2][2][4][2], const Unit& u, int wr, int wc, int fr, int fq) const {
        const int row0 = u.pm * BM + wr * 64 + fr, col0 = u.pn * BM + wc * 32 + 8 * fq;
#pragma unroll
        for (int ai = 0; ai < 2; ++ai)
#pragma unroll
            for (int m = 0; m < 4; ++m) { const int row = row0 + ai * HALF + m * 16;
#pragma unroll
                for (int bj = 0; bj < 2; ++bj) { const u32x4 g = *(const u32x4*)(G + (size_t)row * 8192 + col0 + bj * HALF); const float* tp = T + (size_t)row * 4096 + col0 + bj * HALF;
                    const f32x4 t0 = *(const f32x4*)tp, t1 = *(const f32x4*)(tp + 4);
                    const f32x4 v0 = t0 + acc[ai][bj][m][0] * (f32x4){bf_lo(g.x), bf_hi(g.x), bf_lo(g.y), bf_hi(g.y)};
                    const f32x4 v1 = t1 + acc[ai][bj][m][1] * (f32x4){bf_lo(g.z), bf_hi(g.z), bf_lo(g.w), bf_hi(g.w)};
                    *(u32x4*)(O + (size_t)row * 4096 + col0 + bj * HALF) = pack8(v0, v1); } }
    }
};
struct EpiGateI8 {
    static constexpr bool PERM = true;
    bf16_t *UV, *G; const float *hs, *cs;
    template <int ACT> __device__ __forceinline__ void put(const f32x4 (&acc)[2][2][4][2], bf16_t* dst, int ld, int row0, int col0, int sc0) const {
        f32x4 cv[2][2];
#pragma unroll
        for (int bj = 0; bj < 2; ++bj)
#pragma unroll
            for (int n = 0; n < 2; ++n) cv[bj][n] = *(const f32x4*)(cs + sc0 + bj * HALF + n * 4);
#pragma unroll
        for (int ai = 0; ai < 2; ++ai)
#pragma unroll
            for (int m = 0; m < 4; ++m) { const int row = row0 + ai * HALF + m * 16; const float h = hs[row];
#pragma unroll
                for (int bj = 0; bj < 2; ++bj) {
                    const f32x4 v0 = __builtin_convertvector(__builtin_bit_cast(i32x4, acc[ai][bj][m][0]), f32x4) * (cv[bj][0] * h);
                    const f32x4 v1 = __builtin_convertvector(__builtin_bit_cast(i32x4, acc[ai][bj][m][1]), f32x4) * (cv[bj][1] * h);
                    *(u32x4*)(dst + (size_t)row * ld + col0 + bj * HALF) = pack8(act4<ACT>(v0), act4<ACT>(v1)); } }
    }
    __device__ __forceinline__ void operator()(const f32x4 (&acc)[2][2][4][2], const Unit& u, int wr, int wc, int fr, int fq) const {
        const int row0 = u.pm * BM + wr * 64 + fr, cw = wc * 32 + 8 * fq;
        if (u.pn < UV8 / 256) put<1>(acc, UV, 4096, row0, u.pn * BM + cw, u.pn * BM + cw);
        else put<2>(acc, G, 8192, row0, (u.pn - UV8 / 256) * BM + cw, u.pn * BM + cw);
    }
};
template <int ACT> struct EpiActI8 {
    static constexpr bool PERM = true;
    bf16_t* O; int ld; const float *hs, *cs;
    __device__ __forceinline__ void operator()(const f32x4 (&acc)[2][2][4][2], const Unit& u, int wr, int wc, int fr, int fq) const {
        const int row0 = u.pm * BM + wr * 64 + fr, col0 = u.pn * BM + wc * 32 + 8 * fq;
        f32x4 cv[2][2];
#pragma unroll
        for (int bj = 0; bj < 2; ++bj)
#pragma unroll
            for (int n = 0; n < 2; ++n) cv[bj][n] = *(const f32x4*)(cs + col0 + bj * HALF + n * 4);
#pragma unroll
        for (int ai = 0; ai < 2; ++ai)
#pragma unroll
            for (int m = 0; m < 4; ++m) { const int row = row0 + ai * HALF + m * 16; const float h = hs[row];
#pragma unroll
                for (int bj = 0; bj < 2; ++bj) {
                    const f32x4 v0 = __builtin_convertvector(__builtin_bit_cast(i32x4, acc[ai][bj][m][0]), f32x4) * (cv[bj][0] * h);
                    const f32x4 v1 = __builtin_convertvector(__builtin_bit_cast(i32x4, acc[ai][bj][m][1]), f32x4) * (cv[bj][1] * h);
                    *(u32x4*)(O + (size_t)row * ld + col0 + bj * HALF) = pack8(act4<ACT>(v0), act4<ACT>(v1)); } }
    }
};
struct EpiMixFused {
    static constexpr bool PERM = true, HAS_MID = true;
    const bf16_t* G; bf16_t* O; int tmid;
    __device__ __forceinline__ void mid(f32x4 (&acc)[2][2][4][2], const Unit& u, int wr, int wc, int fr, int fq) const {
        const char* gbase = (const char*)(G + (size_t)(u.pm * BM) * 8192 + u.pn * BM);
        unsigned loff = (unsigned)((wr * 64 + fr) * 8192 + wc * 32 + 8 * fq) * 2u;
        asm volatile("" : "+s"(gbase), "+v"(loff));
#pragma unroll
        for (int ai = 0; ai < 2; ++ai)
#pragma unroll
            for (int m = 0; m < 4; ++m) {
#pragma unroll
                for (int bj = 0; bj < 2; ++bj) { const char* gp = gbase + (size_t)((ai * HALF + m * 16) * 8192 + bj * HALF) * 2;
                    const u32x4 ga = *(const u32x4*)(gp + loff), gb = *(const u32x4*)(gp + 8192 + loff);
                    f32x4 r0, r1;
                    r0[0] = bf_lo(ga.x) * __builtin_amdgcn_rcpf(fmaxf(bf_lo(gb.x), 1e-30f)); r0[1] = bf_hi(ga.x) * __builtin_amdgcn_rcpf(fmaxf(bf_hi(gb.x), 1e-30f));
                    r0[2] = bf_lo(ga.y) * __builtin_amdgcn_rcpf(fmaxf(bf_lo(gb.y), 1e-30f)); r0[3] = bf_hi(ga.y) * __builtin_amdgcn_rcpf(fmaxf(bf_hi(gb.y), 1e-30f));
                    r1[0] = bf_lo(ga.z) * __builtin_amdgcn_rcpf(fmaxf(bf_lo(gb.z), 1e-30f)); r1[1] = bf_hi(ga.z) * __builtin_amdgcn_rcpf(fmaxf(bf_hi(gb.z), 1e-30f));
                    r1[2] = bf_lo(ga.w) * __builtin_amdgcn_rcpf(fmaxf(bf_lo(gb.w), 1e-30f)); r1[3] = bf_hi(ga.w) * __builtin_amdgcn_rcpf(fmaxf(bf_hi(gb.w), 1e-30f));
                    acc[ai][bj][m][0] *= r0; acc[ai][bj][m][1] *= r1; }
                asm volatile("" : "+v"(acc[ai][0][m][0]), "+v"(acc[ai][0][m][1]), "+v"(acc[ai][1][m][0]), "+v"(acc[ai][1][m][1]) :: "memory"); }
    }
    __device__ __forceinline__ void operator()(const f32x4 (&acc)[2][2][4][2], const Unit& u, int wr, int wc, int fr, int fq) const {
        const int row0 = u.pm * BM + wr * 64 + fr, col0 = u.pn * BM + wc * 32 + 8 * fq;
#pragma unroll
        for (int ai = 0; ai < 2; ++ai)
#pragma unroll
            for (int m = 0; m < 4; ++m) { const int row = row0 + ai * HALF + m * 16;
#pragma unroll
                for (int bj = 0; bj < 2; ++bj) { const u32x4 g = *(const u32x4*)(G + (size_t)row * 8192 + 4096 + col0 + bj * HALF);
                    const f32x4 v0 = acc[ai][bj][m][0] * (f32x4){bf_lo(g.x), bf_hi(g.x), bf_lo(g.y), bf_hi(g.y)};
                    const f32x4 v1 = acc[ai][bj][m][1] * (f32x4){bf_lo(g.z), bf_hi(g.z), bf_lo(g.w), bf_hi(g.w)};
                    *(u32x4*)(O + (size_t)row * 4096 + col0 + bj * HALF) = pack8(v0, v1); } }
    }
};
struct EpiMixI8 {
    static constexpr bool PERM = true, HAS_MID = true;
    const bf16_t* G; bf16_t* O; int tmid; const float *sa, *sb, *cs;
    template <bool FIN> __device__ __forceinline__ void run(f32x4 (&acc)[2][2][4][2], const Unit& u, int wr, int wc, int fr, int fq) const {
        const char* gbase = (const char*)(G + (size_t)(u.pm * BM) * 8192 + u.pn * BM + (FIN ? 4096 : 0));
        char* obase = (char*)(O + (size_t)(u.pm * BM) * 4096 + u.pn * BM);
        const char* cbase = (const char*)(cs + u.pn * BM); const char* rbase = (const char*)((FIN ? sb : sa) + u.pm * BM);
        unsigned goff = (unsigned)((wr * 64 + fr) * 8192 + wc * 32 + 8 * fq) * 2u, ooff = (unsigned)((wr * 64 + fr) * 4096 + wc * 32 + 8 * fq) * 2u, coff = (unsigned)(wc * 32 + 8 * fq) * 4u, roff = (unsigned)(wr * 64 + fr) * 4u;
        asm volatile("" : "+s"(gbase), "+s"(obase), "+s"(cbase), "+s"(rbase), "+v"(goff), "+v"(ooff), "+v"(coff), "+v"(roff));
        f32x4 cv[2][2];
#pragma unroll
        for (int bj = 0; bj < 2; ++bj) { cv[bj][0] = *(const f32x4*)(cbase + coff + bj * HALF * 4); cv[bj][1] = *(const f32x4*)(cbase + coff + bj * HALF * 4 + 16); }
#pragma unroll
        for (int ai = 0; ai < 2; ++ai)
#pragma unroll
            for (int m = 0; m < 4; ++m) { const int rl = ai * HALF + m * 16; const float rs = *(const float*)(rbase + roff + rl * 4);
#pragma unroll
                for (int bj = 0; bj < 2; ++bj) {
                    const u32x4 g = *(const u32x4*)(gbase + goff + (size_t)(rl * 8192 + bj * HALF) * 2);
                    char* op = obase + ooff + (size_t)(rl * 4096 + bj * HALF) * 2;
                    f32x4 v0 = __builtin_convertvector(__builtin_bit_cast(i32x4, acc[ai][bj][m][0]), f32x4) * (cv[bj][0] * rs) * (f32x4){bf_lo(g.x), bf_hi(g.x), bf_lo(g.y), bf_hi(g.y)};
                    f32x4 v1 = __builtin_convertvector(__builtin_bit_cast(i32x4, acc[ai][bj][m][1]), f32x4) * (cv[bj][1] * rs) * (f32x4){bf_lo(g.z), bf_hi(g.z), bf_lo(g.w), bf_hi(g.w)};
                    if constexpr (FIN) { const u32x4 pk = *(const u32x4*)op;
                        v0 += (f32x4){bf_lo(pk.x), bf_hi(pk.x), bf_lo(pk.y), bf_hi(pk.y)}; v1 += (f32x4){bf_lo(pk.z), bf_hi(pk.z), bf_lo(pk.w), bf_hi(pk.w)}; }
                    *(u32x4*)op = pack8(v0, v1);
                    if constexpr (!FIN) { acc[ai][bj][m][0] = (f32x4){0.f, 0.f, 0.f, 0.f}; acc[ai][bj][m][1] = (f32x4){0.f, 0.f, 0.f, 0.f}; } }
                if constexpr (!FIN) asm volatile("" : "+v"(acc[ai][0][m][0]), "+v"(acc[ai][0][m][1]), "+v"(acc[ai][1][m][0]), "+v"(acc[ai][1][m][1]) :: "memory"); }
    }
    __device__ __forceinline__ void mid(f32x4 (&acc)[2][2][4][2], const Unit& u, int wr, int wc, int fr, int fq) const { run<false>(acc, u, wr, wc, fr, fq); }
    __device__ __forceinline__ void operator()(const f32x4 (&acc)[2][2][4][2], const Unit& u, int wr, int wc, int fr, int fq) const { run<true>(const_cast<f32x4 (&)[2][2][4][2]>(acc), u, wr, wc, fr, fq); }
};
struct EpiRes {
    static constexpr bool PERM = false;
    const float* base; float* out; const float* mod;
    __device__ __forceinline__ void operator()(const f32x4 (&acc)[2][2][4][2], const Unit& u, int wr, int wc, int fr, int fq) const {
        const int row0 = u.pm * BM + wr * 64 + fr, col0 = u.pn * BM + wc * 32 + 4 * fq;
        const float* mb = mod + (size_t)(u.pm >> 3) * 24576 + col0;
        f32x4 gv[2][2];
#pragma unroll
        for (int bj = 0; bj < 2; ++bj)
#pragma unroll
            for (int n = 0; n < 2; ++n) gv[bj][n] = *(const f32x4*)(mb + bj * HALF + n * 16);
#pragma unroll
        for (int ai = 0; ai < 2; ++ai)
#pragma unroll
            for (int m = 0; m < 4; ++m) { const size_t off = (size_t)(row0 + ai * HALF + m * 16) * 4096 + col0;
#pragma unroll
                for (int bj = 0; bj < 2; ++bj)
#pragma unroll
                    for (int n = 0; n < 2; ++n) { const f32x4 b = *(const f32x4*)(base + off + bj * HALF + n * 16); *(f32x4*)(out + off + bj * HALF + n * 16) = b + gv[bj][n] * acc[ai][bj][m][n]; } }
    }
};

template <class T, class = void> struct has_mid { static constexpr bool value = false; };
template <class T> struct has_mid<T, decltype((void)T::HAS_MID)> { static constexpr bool value = T::HAS_MID; };
struct EpiResI8 {
    static constexpr bool PERM = true;
    const float* base; float* out; const float* mod; const float *ms, *cs;
    __device__ __forceinline__ void operator()(const f32x4 (&acc)[2][2][4][2], const Unit& u, int wr, int wc, int fr, int fq) const {
        const int row0 = u.pm * BM + wr * 64 + fr, col0 = u.pn * BM + wc * 32 + 8 * fq;
        const float* mb = mod + (size_t)(u.pm >> 3) * 24576 + col0;
        f32x4 gv[2][2];
#pragma unroll
        for (int bj = 0; bj < 2; ++bj)
#pragma unroll
            for (int n = 0; n < 2; ++n) gv[bj][n] = *(const f32x4*)(mb + bj * HALF + n * 4) * *(const f32x4*)(cs + col0 + bj * HALF + n * 4);
#pragma unroll
        for (int ai = 0; ai < 2; ++ai)
#pragma unroll
            for (int m = 0; m < 4; ++m) { const int row = row0 + ai * HALF + m * 16; const size_t off = (size_t)row * 4096 + col0; const float rs = ms[row];
#pragma unroll
                for (int bj = 0; bj < 2; ++bj)
#pragma unroll
                    for (int n = 0; n < 2; ++n) { const f32x4 b = *(const f32x4*)(base + off + bj * HALF + n * 4);
                        *(f32x4*)(out + off + bj * HALF + n * 4) = b + (gv[bj][n] * rs) * __builtin_convertvector(__builtin_bit_cast(i32x4, acc[ai][bj][m][n]), f32x4); } }
    }
};

template <class Epi, class Sched, bool ALIGN_EPI = PG8_ALIGN, bool SP2 = PG8_SP2, bool I8 = false>
__device__ __forceinline__ void gemm_phase(PG8_LAS unsigned char* lds, const Gemm g, const Sched& S, const Epi& E, const int wid) {
    const int lane = lane_id(), tid = wid * 64 + lane, wr = wid >> 2, wc = wid & 3, fr = lane & 15, fq = lane >> 4;
    const int K = g.K, nt = K / BK;
    unsigned voffA[2], voffB[2];
#pragma unroll
    for (int i = 0; i < 2; ++i) { int R, C; stage_rc(tid * 16 + i * 8192, R, C); const int Rb = Epi::PERM ? ((R & ~31) + perm32(R & 31)) : R;
        voffA[i] = (unsigned)(R * g.lda + C) * 2u; voffB[i] = (unsigned)(Rb * g.ldb + C) * 2u; }
    const size_t kstep = (size_t)(BK * 2);
    const size_t hstepA = (size_t)HALF * g.lda * 2, hstepB = (size_t)HALF * g.ldb * 2;
    const size_t tstepA = 2 * hstepA, tstepB = 2 * hstepB;
    const unsigned ldsw = (unsigned)wid * 1024u;
    const int aoff = lds_byte(wr * 64 + fr, fq * 8), boff = lds_byte(wc * 32 + fr, fq * 8);
#define PG8_SA(b, h) (((b) * 2 + (h)) * HTB)
#define PG8_SB(b, h) ((4 + (b) * 2 + (h)) * HTB)
#define PG8_STAGE(bufoff, gbase, voff) do { _Pragma("unroll") for (int _i = 0; _i < 2; ++_i) \
        __builtin_amdgcn_global_load_lds((const unsigned*)((const char*)(gbase) + (voff)[_i]), (PG8_LAS unsigned*)(lds + (bufoff) + ldsw + _i * 8192), 16, 0, 0); } while (0)
#define PG8_LDA(dst, b, h) do { _Pragma("unroll") for (int m = 0; m < 4; ++m) _Pragma("unroll") for (int k = 0; k < 2; ++k) dst[m][k] = *(const PG8_LAS bf16x8*)(lds + PG8_SA(b, h) + aoff + m * 2048 + k * 1024); } while (0)
#define PG8_LDB(dst, b, h) do { _Pragma("unroll") for (int n = 0; n < 2; ++n) _Pragma("unroll") for (int k = 0; k < 2; ++k) dst[n][k] = *(const PG8_LAS bf16x8*)(lds + PG8_SB(b, h) + boff + n * 2048 + k * 1024); } while (0)
#define PG8_MMA(ai, bj, At, Bt) do { __builtin_amdgcn_s_setprio(1); _Pragma("unroll") for (int m = 0; m < 4; ++m) _Pragma("unroll") for (int n = 0; n < 2; ++n) _Pragma("unroll") for (int k = 0; k < 2; ++k) \
        { if constexpr (I8) acc[ai][bj][m][n] = __builtin_bit_cast(f32x4, __builtin_amdgcn_mfma_i32_16x16x64_i8(__builtin_bit_cast(i32x4, Bt[n][k]), __builtin_bit_cast(i32x4, At[m][k]), __builtin_bit_cast(i32x4, acc[ai][bj][m][n]), 0, 0, 0)); \
          else acc[ai][bj][m][n] = __builtin_amdgcn_mfma_f32_16x16x32_bf16(Bt[n][k], At[m][k], acc[ai][bj][m][n], 0, 0, 0); } __builtin_amdgcn_s_setprio(0); } while (0)
#define PG8_WAIT_V(n) asm volatile("s_waitcnt vmcnt(" #n ")" ::: "memory")
#define PG8_WAIT_L(n) asm volatile("s_waitcnt lgkmcnt(" #n ")" ::: "memory")
#define PG8_BAR __builtin_amdgcn_s_barrier()
#define PG8_SCHED __builtin_amdgcn_sched_barrier(0)
    Unit cur, nxt; int ui = 0;
    if (!S.next(0, cur)) return;
    f32x4 acc[2][2][4][2];
#pragma unroll
    for (int a = 0; a < 2; ++a)
#pragma unroll
        for (int b = 0; b < 2; ++b)
#pragma unroll
            for (int m = 0; m < 4; ++m)
#pragma unroll
                for (int n = 0; n < 2; ++n) acc[a][b][m][n] = (f32x4){0.f, 0.f, 0.f, 0.f};
    bf16x8 At[4][2], B0[2][2], B1[2][2];
    const char* cA = (const char*)g.A + (size_t)cur.pm * tstepA; const char* cB = (const char*)g.Bt + (size_t)cur.pn * tstepB;
    if constexpr (SP2) {
    PG8_STAGE(PG8_SB(0, 0), cB, voffB); PG8_STAGE(PG8_SB(0, 1), cB + hstepB, voffB); PG8_STAGE(PG8_SA(0, 0), cA, voffA); PG8_STAGE(PG8_SA(0, 1), cA + hstepA, voffA);
    if (wr == 1) PG8_BAR;
    PG8_WAIT_V(2); PG8_BAR;
    PG8_STAGE(PG8_SB(1, 0), cB + kstep, voffB); PG8_STAGE(PG8_SA(1, 0), cA + kstep, voffA); PG8_STAGE(PG8_SB(1, 1), cB + hstepB + kstep, voffB);
    PG8_WAIT_V(6); PG8_BAR;
    } else {
    PG8_STAGE(PG8_SB(0, 0), cB, voffB); PG8_STAGE(PG8_SA(0, 0), cA, voffA); PG8_STAGE(PG8_SB(0, 1), cB + hstepB, voffB); PG8_STAGE(PG8_SA(0, 1), cA + hstepA, voffA);
    if (wr == 1) PG8_BAR;
    PG8_WAIT_V(4); PG8_BAR;
    PG8_STAGE(PG8_SB(1, 0), cB + kstep, voffB); PG8_STAGE(PG8_SA(1, 0), cA + kstep, voffA); PG8_STAGE(PG8_SB(1, 1), cB + hstepB + kstep, voffB);
    PG8_WAIT_V(6); PG8_BAR;
    }
    for (;;) {
        const bool has_next = S.next(ui + 1, nxt);
        const char* nA = has_next ? (const char*)g.A + (size_t)nxt.pm * tstepA : cA; const char* nB = has_next ? (const char*)g.Bt + (size_t)nxt.pn * tstepB : cB;
        asm volatile(".p2align 6");
        for (int t = 0; t < nt; t += 2) {
            if constexpr (has_mid<Epi>::value) { if (t == E.tmid) E.mid(acc, cur, wr, wc, fr, fq); }
            const bool last = (t == nt - 2);
            const char* a1 = cA + (size_t)(t + 1) * kstep;
            const char* a2 = last ? nA : cA + (size_t)(t + 2) * kstep; const char* b2 = last ? nB : cB + (size_t)(t + 2) * kstep;
            const char* a3 = a2 + kstep; const char* b3 = b2 + kstep;
            if constexpr (SP2) {
            PG8_LDB(B0, 0, 0); PG8_LDB(B1, 0, 1); PG8_SCHED; PG8_LDA(At, 0, 0); PG8_STAGE(PG8_SA(1, 1), a1 + hstepA, voffA);
            PG8_WAIT_V(8); PG8_WAIT_L(0); PG8_BAR; PG8_MMA(0, 0, At, B0); PG8_MMA(0, 1, At, B1); PG8_BAR; PG8_SCHED;
            PG8_LDA(At, 0, 1); PG8_STAGE(PG8_SB(0, 0), b2, voffB); PG8_STAGE(PG8_SB(0, 1), b2 + hstepB, voffB); PG8_STAGE(PG8_SA(0, 0), a2, voffA);
            PG8_WAIT_V(8); PG8_WAIT_L(0); PG8_BAR; PG8_MMA(1, 0, At, B0); PG8_MMA(1, 1, At, B1); PG8_BAR; PG8_SCHED;
            PG8_LDB(B0, 1, 0); PG8_LDB(B1, 1, 1); PG8_SCHED; PG8_LDA(At, 1, 0); PG8_STAGE(PG8_SA(0, 1), a2 + hstepA, voffA);
            PG8_WAIT_V(8); PG8_WAIT_L(0); PG8_BAR; PG8_MMA(0, 0, At, B0); PG8_MMA(0, 1, At, B1); PG8_BAR; PG8_SCHED;
            PG8_LDA(At, 1, 1); PG8_STAGE(PG8_SB(1, 0), b3, voffB); PG8_STAGE(PG8_SB(1, 1), b3 + hstepB, voffB); PG8_STAGE(PG8_SA(1, 0), a3, voffA);
            PG8_WAIT_V(8); PG8_WAIT_L(0); PG8_BAR; PG8_MMA(1, 0, At, B0); PG8_MMA(1, 1, At, B1); PG8_BAR; PG8_SCHED;
            } else {
            PG8_LDB(B0, 0, 0); PG8_SCHED; PG8_LDA(At, 0, 0); PG8_STAGE(PG8_SA(1, 1), a1 + hstepA, voffA);
            PG8_WAIT_L(8); PG8_BAR; PG8_WAIT_L(0); PG8_MMA(0, 0, At, B0); PG8_BAR; PG8_SCHED;
            PG8_LDB(B1, 0, 1); PG8_STAGE(PG8_SB(0, 0), b2, voffB);
            PG8_BAR; PG8_WAIT_L(0); PG8_MMA(0, 1, At, B1); PG8_BAR;
            PG8_LDA(At, 0, 1); PG8_STAGE(PG8_SA(0, 0), a2, voffA);
            PG8_BAR; PG8_WAIT_L(0); PG8_MMA(1, 0, At, B0); PG8_BAR; PG8_SCHED;
            PG8_STAGE(PG8_SB(0, 1), b2 + hstepB, voffB);
            PG8_WAIT_V(6); PG8_BAR; PG8_MMA(1, 1, At, B1); PG8_BAR;
            PG8_LDB(B0, 1, 0); PG8_SCHED; PG8_LDA(At, 1, 0); PG8_STAGE(PG8_SA(0, 1), a2 + hstepA, voffA);
            PG8_WAIT_L(8); PG8_BAR; PG8_WAIT_L(0); PG8_MMA(0, 0, At, B0); PG8_BAR; PG8_SCHED;
            PG8_LDB(B1, 1, 1); PG8_STAGE(PG8_SB(1, 0), b3, voffB);
            PG8_BAR; PG8_WAIT_L(0); PG8_MMA(0, 1, At, B1); PG8_BAR;
            PG8_LDA(At, 1, 1); PG8_STAGE(PG8_SA(1, 0), a3, voffA);
            PG8_BAR; PG8_WAIT_L(0); PG8_MMA(1, 0, At, B0); PG8_BAR; PG8_SCHED;
            PG8_STAGE(PG8_SB(1, 1), b3 + hstepB, voffB);
            PG8_WAIT_V(6); PG8_BAR; PG8_MMA(1, 1, At, B1); PG8_BAR;
            }
        }
        if constexpr (ALIGN_EPI) { if (wr == 0) PG8_BAR; }
        E(acc, cur, wr, wc, fr, fq);
        if (!has_next) break;
#pragma unroll
        for (int a = 0; a < 2; ++a)
#pragma unroll
            for (int b = 0; b < 2; ++b)
#pragma unroll
                for (int m = 0; m < 4; ++m)
#pragma unroll
                    for (int n = 0; n < 2; ++n) acc[a][b][m][n] = (f32x4){0.f, 0.f, 0.f, 0.f};
        cur = nxt; cA = nA; cB = nB; ++ui;
        if constexpr (ALIGN_EPI) { if (wr == 1) PG8_BAR; }
    }
    PG8_WAIT_V(0);
    if constexpr (!ALIGN_EPI) { if (wr == 0) PG8_BAR; }
    PG8_BAR;
#undef PG8_SA
#undef PG8_SB
#undef PG8_STAGE
#undef PG8_LDA
#undef PG8_LDB
#undef PG8_MMA
#undef PG8_WAIT_V
#undef PG8_WAIT_L
#undef PG8_BAR
#undef PG8_SCHED
}
}

constexpr int NWAVES = 8;
constexpr int BATCH = 4, SEQ = 2048, DM = 4096, M = BATCH * SEQ;
constexpr int GMW = 2048, NH = 32, QKH = 192, VH = 128, QLORA = 1024, KVLORA = 512, DFF = 16384, NMODC = 6 * DM;
constexpr int IN_COLS = 13888, OFF_GATE = 5696, NPAD = 14080, NP_GATE = 5888;
constexpr float EPS = 1e-6f;
constexpr float QSCALE = 0.07216878364870322f * 1.4426950408889634f;
constexpr int KSPLIT = 32, KCH = DM / KSPLIT;

constexpr size_t MiB = 1u << 20;
constexpr size_t WS_CTL = 0, CTL_ZERO_BYTES = 64 * 1024;
constexpr size_t WS_MOD = 1 * MiB, WS_STATS = 2 * MiB, WS_ROPE = 3 * MiB, WS_MODP = 5 * MiB;
constexpr size_t WS_WIN = 20 * MiB, WS_WUQ = 130 * MiB, WS_WUKV = 142 * MiB, WS_WAB = 150 * MiB, WS_WOUT = 198 * MiB, WS_WFF1 = 230 * MiB, WS_WFF2 = 358 * MiB;
constexpr size_t WS_H = 486 * MiB, WS_UV = 550 * MiB, WS_QL = 614 * MiB, WS_KVL = 630 * MiB, WS_KPE = 638 * MiB, WS_GATES = 642 * MiB, WS_AO = 770 * MiB;
constexpr size_t WS_Q = 866 * MiB, WS_KN = 962 * MiB, WS_V = 1026 * MiB, WS_K = 1090 * MiB, WS_MIXED = 1186 * MiB, WS_END = 1250 * MiB;
constexpr int NQ8 = UV8 + 8192;
constexpr size_t WS_WG8 = WS_WIN + 46 * MiB, WS_H8 = UV8 ? WS_WIN : WS_WIN + 78 * MiB;
constexpr size_t WS_CMAXP = WS_KN + 54 * MiB  , WS_CS = WS_KN + 2 * MiB, WS_HS = WS_KN + 3 * MiB;
constexpr int FF8 = 16384;
constexpr size_t WS_CMAXF = WS_KN + 40 * MiB, WS_CSF = WS_KN + 46 * MiB;
constexpr size_t WS_MS = WS_KN + 4 * MiB, WS_CSO = WS_KN + 5 * MiB, WS_CMAXO = WS_KN + 6 * MiB, WS_M8 = WS_KN + 8 * MiB;
constexpr size_t WS_CMAXAB = WS_KN + 48 * MiB, WS_CSAB = WS_KN + 50 * MiB, WS_SA = WS_KN + 51 * MiB, WS_SB = WS_KN + 52 * MiB, WS_A8 = WS_Q;
constexpr size_t WS_T = WS_Q;
constexpr size_t WS_F1 = WS_UV;
static_assert(WS_T + (size_t)M * 4096 * 4 <= WS_V && WS_F1 + (size_t)M * DFF * 2 <= WS_Q, "overlays");
constexpr int CW_BAR = 4096;

constexpr int RING_BYTES = 131072, LDS_BYTES = 163840, LDSCTL_OFF = LDS_BYTES - 512, MISC_OFF = LDSCTL_OFF + 320;

#define GAS __attribute__((address_space(1)))
#define LAS __attribute__((address_space(3)))
typedef unsigned short bf16;
typedef unsigned v4u __attribute__((ext_vector_type(4)));
typedef unsigned v2u __attribute__((ext_vector_type(2)));
typedef float f32x4 __attribute__((ext_vector_type(4)));
typedef float f32x16 __attribute__((ext_vector_type(16)));
typedef short bf16x8 __attribute__((ext_vector_type(8)));
typedef short s16x4 __attribute__((ext_vector_type(4)));
typedef GAS unsigned gu32;
#define RLX_AGENT __ATOMIC_RELAXED, __HIP_MEMORY_SCOPE_AGENT
#define LDS_WAIT() asm volatile("s_waitcnt lgkmcnt(0)" ::: "memory")
#define VM_WAIT() asm volatile("s_waitcnt vmcnt(0)" ::: "memory")
__device__ __forceinline__ unsigned f2bf(float f) { unsigned u = __builtin_bit_cast(unsigned, f); return (u + 0x7fffu + ((u >> 16) & 1u)) >> 16; }
__device__ __forceinline__ unsigned pk2(float lo, float hi) { return f2bf(lo) | (f2bf(hi) << 16); }
__device__ __forceinline__ float bflo(unsigned w) { return __uint_as_float(w << 16); }
__device__ __forceinline__ float bfhi(unsigned w) { return __uint_as_float(w & 0xffff0000u); }
__device__ __forceinline__ float wave_sum(float v) {
#pragma unroll
    for (int o = 1; o < 64; o <<= 1) v += __shfl_xor(v, o);
    return v;
}

#define XB_TMO      128
#define XB_XCNT(j)  (256  + 64 * (j))
#define XB_XSUB(j)  (1280 + 64 * (j))
#define XB_XGEN(j)  (2304 + 64 * (j))
#define XB_TOP      3328
#define XB_TOPGEN   3392
#define XCD_BAR_WORDS 3456
#define XB_SPIN_CAP (1u << 18)
__device__ __forceinline__ unsigned xb_ld(unsigned* p)              { return __hip_atomic_load(p, __ATOMIC_RELAXED, __HIP_MEMORY_SCOPE_AGENT); }
__device__ __forceinline__ unsigned xb_add(unsigned* p, unsigned v) { return __hip_atomic_fetch_add(p, v, __ATOMIC_RELAXED, __HIP_MEMORY_SCOPE_AGENT); }
__device__ __forceinline__ unsigned xb_xcc_id() { return (unsigned)__builtin_amdgcn_s_getreg((3 << 11) | 20) & 0xFu; }
#define XB_SPIN(cond, bar) do { unsigned _sp = 0; while (cond) { __builtin_amdgcn_s_sleep(1); \
    if ((++_sp & 255u) == 0u) { if (xb_ld(&(bar)[XB_TMO])) break; if (_sp > XB_SPIN_CAP) { atomicAdd(&(bar)[XB_TMO], 1u); break; } } } } while (0)
struct XcdBarrier { unsigned* bar; unsigned x; volatile LAS unsigned* st; int wave; };
__device__ __forceinline__ XcdBarrier xcd_barrier_post(unsigned* bar, volatile LAS unsigned* st, int wave) {
    XcdBarrier b; b.bar = bar; b.x = xb_xcc_id(); b.st = st; b.wave = wave;
    if (wave == 0 && pg8::lane_id() == 0) (void)xb_add(&bar[XB_XCNT(b.x)], 1u);
    return b;
}
__device__ __forceinline__ void xcd_barrier_complete(unsigned* bar, unsigned x, unsigned& nloc, unsigned& nx) {
    const unsigned G = gridDim.x * gridDim.y * gridDim.z;
    unsigned sum, cnt, mine, sp = 0u;
    for (;;) {
        sum = 0u; cnt = 0u; mine = 0u;
#pragma unroll
        for (unsigned j = 0; j < 16; ++j) { const unsigned c = xb_ld(&bar[XB_XCNT(j)]); sum += c; cnt += (c > 0u) ? 1u : 0u; mine = (j == x) ? c : mine; }
        if (sum == G) break;
        __builtin_amdgcn_s_sleep(1);
        if ((++sp & 255u) == 0u) { if (xb_ld(&bar[XB_TMO])) break; if (sp > XB_SPIN_CAP) { atomicAdd(&bar[XB_TMO], 1u); break; } }
    }
    nloc = mine > 0u ? mine : 1u; nx = cnt > 0u ? cnt : 1u;
}
__device__ __forceinline__ void xcd_barrier(const XcdBarrier& b) {
    asm volatile("s_waitcnt vmcnt(0)" ::: "memory");
    __syncthreads();
    if (b.wave == 0 && pg8::lane_id() == 0) {
        unsigned* bar = b.bar;
        __builtin_amdgcn_s_waitcnt(0);
        unsigned nloc = b.st[0], nx = b.st[1];
        if (nloc == 0u) { xcd_barrier_complete(bar, b.x, nloc, nx); b.st[0] = nloc; b.st[1] = nx; }
        const unsigned old = xb_add(&bar[XB_XSUB(b.x)], 1u);
        const unsigned gen = old / nloc;
        if (old + 1u == (gen + 1u) * nloc) {
            __builtin_amdgcn_fence(__ATOMIC_RELEASE, "agent");
            asm volatile("s_waitcnt vmcnt(0)" ::: "memory");
            const unsigned og = xb_add(&bar[XB_TOP], 1u);
            const unsigned tg = og / nx;
            if (og + 1u == (tg + 1u) * nx) xb_add(&bar[XB_TOPGEN], 1u);
            else XB_SPIN(xb_ld(&bar[XB_TOPGEN]) == tg, bar);
            __builtin_amdgcn_fence(__ATOMIC_ACQUIRE, "agent");
            xb_add(&bar[XB_XGEN(b.x)], 1u);
            asm volatile("s_waitcnt vmcnt(0)" ::: "memory");
        } else {
            XB_SPIN(xb_ld(&bar[XB_XGEN(b.x)]) == gen, bar);
            __builtin_amdgcn_fence(__ATOMIC_ACQUIRE, "agent");
            asm volatile("s_waitcnt vmcnt(0)" ::: "memory");
        }
    }
    __syncthreads();
}

struct Args { const float* in[22]; float* out; unsigned char* ws; float inv_freq[32]; int ph_lo, ph_hi; };
__device__ __forceinline__ f32x4 had4(const f32x4 v) { const float a = v.x + v.y, b = v.x - v.y, c = v.z + v.w, d = v.z - v.w; return (f32x4){a + c, b + d, a - c, b - d}; }
template <int CTRL> __device__ __forceinline__ float dpp_f(const float v) { return __int_as_float(__builtin_amdgcn_mov_dpp(__float_as_int(v), CTRL, 0xf, 0xf, true)); }
__device__ __forceinline__ float had_x(const float v, const int m, const int lane) {
    float p;
    if (m == 1) p = dpp_f<0xB1>(v);
    else if (m == 2) p = dpp_f<0x4E>(v);
    else if (m == 4) { const float up = dpp_f<0x104>(v), dn = dpp_f<0x114>(v); p = (lane & 4) ? dn : up; }
    else { const float up = dpp_f<0x108>(v), dn = dpp_f<0x118>(v); p = (lane & 8) ? dn : up; }
    return __builtin_fmaf(v, (lane & m) ? -1.0f : 1.0f, p);
}
template <int N_> __device__ __forceinline__ void had_reg(float (&w)[N_]) {
#pragma unroll
    for (int b = 1; b < N_; b <<= 1)
#pragma unroll
        for (int i = 0; i < N_; ++i) if (!(i & b)) { const float a = w[i], c = w[i + b]; w[i] = a + c; w[i + b] = a - c; }
}
template <bool NT = false> __device__ __forceinline__ float rot_colmax64(const float* wp, const size_t ld) {
    float w[64];
#pragma unroll
    for (int kk = 0; kk < 64; ++kk) w[kk] = NT ? __builtin_nontemporal_load(wp + (size_t)kk * ld) : wp[(size_t)kk * ld];
    had_reg<64>(w);
    float mx = 0.f;
#pragma unroll
    for (int kk = 0; kk < 64; ++kk) mx = fmaxf(mx, fabsf(w[kk]));
    return mx;
}
struct Frame {
    LAS unsigned char* lds; int wave, vcu, G;
};

__device__ __forceinline__ void p0_transpose_item(const float* W, int N, bf16* WT, int ldt, int row_add, const float* gain, LAS float* scr, int kb, int nb, int lane) {
    const int k0 = 64 * kb, n0 = 32 * nb;
    { const float* wp = W + (size_t)(k0 + (lane >> 5)) * N + n0 + (lane & 31);
      float w[32];
#pragma unroll
      for (int i = 0; i < 32; ++i) w[i] = wp[(size_t)(2 * i) * N];
      if (gain) {
#pragma unroll
          for (int i = 0; i < 32; ++i) w[i] *= gain[k0 + 2 * i + (lane >> 5)]; }
#pragma unroll
      for (int i = 0; i < 32; ++i) scr[(2 * i + (lane >> 5)) * 33 + (lane & 31)] = w[i]; }
    LDS_WAIT(); asm volatile("" ::: "memory");
    const int c = lane & 7;
#pragma unroll
    for (int j = 0; j < 4; ++j) { const int n = (lane >> 3) + 8 * j; const LAS float* s = scr + (8 * c) * 33 + n;
        v4u o; o.x = pk2(s[0 * 33], s[1 * 33]); o.y = pk2(s[2 * 33], s[3 * 33]); o.z = pk2(s[4 * 33], s[5 * 33]); o.w = pk2(s[6 * 33], s[7 * 33]);
        *(v4u*)(WT + (size_t)(row_add + n0 + n) * ldt + k0 + 8 * c) = o; }
    LDS_WAIT(); asm volatile("" ::: "memory");
}
__device__ __forceinline__ void quant_transpose_item(const float* W, int N, signed char* WQ, int ldq, const float* step, LAS float* scr, int kb, int nb, int lane) {
    const int k0 = 64 * kb, n0 = 32 * nb;
    { const float* wp = W + (size_t)(k0 + (lane >> 5)) * N + n0 + (lane & 31);
      float w[32];
#pragma unroll
      for (int i = 0; i < 32; ++i) w[i] = wp[(size_t)(2 * i) * N];
#pragma unroll
      for (int i = 0; i < 32; ++i) scr[(2 * i + (lane >> 5)) * 33 + (lane & 31)] = w[i]; }
    LDS_WAIT(); asm volatile("" ::: "memory");
    const int c = lane & 7;
#pragma unroll
    for (int j = 0; j < 4; ++j) { const int n = (lane >> 3) + 8 * j; const LAS float* sp = scr + (8 * c) * 33 + n;
        const float st = step[n0 + n], inv = st > 0.f ? 1.0f / st : 0.f;
        int q[8]; float wv[8];
#pragma unroll
        for (int e = 0; e < 8; ++e) wv[e] = sp[e * 33];
        had_reg<8>(wv);
#pragma unroll
        for (int e = 0; e < 8; ++e) { wv[e] = had_x(wv[e], 1, lane); wv[e] = had_x(wv[e], 2, lane); wv[e] = had_x(wv[e], 4, lane); }
#pragma unroll
        for (int e = 0; e < 8; ++e) q[e] = (int)__float_as_uint(__builtin_fmaf(wv[e], inv, 12582912.0f));
        { const unsigned a01 = __builtin_amdgcn_perm((unsigned)q[1], (unsigned)q[0], 0x0c0c0400u), a23 = __builtin_amdgcn_perm((unsigned)q[3], (unsigned)q[2], 0x0c0c0400u), a45 = __builtin_amdgcn_perm((unsigned)q[5], (unsigned)q[4], 0x0c0c0400u), a67 = __builtin_amdgcn_perm((unsigned)q[7], (unsigned)q[6], 0x0c0c0400u);
          *(v2u*)(WQ + (size_t)(n0 + n) * ldq + k0 + 8 * c) = (v2u){__builtin_amdgcn_perm(a23, a01, 0x05040100u), __builtin_amdgcn_perm(a67, a45, 0x05040100u)}; } }
    LDS_WAIT(); asm volatile("" ::: "memory");
}
__device__ __forceinline__ void sincos_acc(float ang, float& c, float& s) {
    const double x = (double)ang, k = __builtin_rint(x * 0.15915494309189535), r = (x - k * 6.283185307179586) - k * 2.4492935982947064e-16, r2 = r * r;
    double sp = 1.0 / 2.585201673888498e22, cp = 1.0 / 6.204484017332394e23;
    const double sf[11] = {1.0 / 5.109094217170944e19, 1.0 / 1.21645100408832e17, 1.0 / 3.55687428096e14, 1.0 / 1.307674368e12, 1.0 / 6.2270208e9, 1.0 / 3.99168e7, 1.0 / 362880.0, 1.0 / 5040.0, 1.0 / 120.0, 1.0 / 6.0, 1.0};
    const double cf[12] = {1.0 / 1.1240007277776077e21, 1.0 / 2.43290200817664e18, 1.0 / 6.402373705728e15, 1.0 / 2.0922789888e13, 1.0 / 8.71782912e10, 1.0 / 4.790016e8, 1.0 / 3628800.0, 1.0 / 40320.0, 1.0 / 720.0, 1.0 / 24.0, 1.0 / 2.0, 1.0};
#pragma unroll
    for (int i = 0; i < 11; ++i) sp = sf[i] - sp * r2;
#pragma unroll
    for (int i = 0; i < 12; ++i) cp = cf[i] - cp * r2;
    s = (float)(sp * r); c = (float)cp;
}

#define SBAR() __builtin_amdgcn_sched_barrier(0)
constexpr int SHM_V = 64 * 128 * 2;
constexpr int KPITCH = 400, SHM_K = 64 * KPITCH;
__device__ __forceinline__ int v_st(int k, int c) { const int kk = (k & ~0xC) | ((k & 4) << 1) | ((k & 8) >> 1); return ((kk >> 3) * 4 + (c >> 5)) * 512 + ((kk & 7) * 32 + (c & 31)) * 2; }
__device__ __forceinline__ int v_rd_base(int lane) { return ((lane & 3) << 3) | (((lane >> 2) & 3) << 6) | (((lane >> 4) & 1) << 5) | (((lane >> 5) & 1) << 8); }
constexpr int v_rd_off(int d0, int ks, int half) { return d0 * 512 + ks * 4096 + half * 2048; }
__device__ __forceinline__ int crow(int r, int hi) { return (r & 3) + 8 * (r >> 2) + 4 * hi; }
__device__ __forceinline__ unsigned cvtpk(float lo, float hi) { return pg8::cvt_pk_bf16(lo, hi); }
template <int VOFF>
__device__ __forceinline__ void pv_tile(f32x16* o, int vb0, bf16x8 pa0, bf16x8 pa1, bf16x8 pa2, bf16x8 pa3) {
#define TRRD(dst, off) asm volatile("ds_read_b64_tr_b16 %0, %1 offset:%2" : "=&v"(dst) : "v"(vb0), "i"(off) : "memory")
#define PV_D0(d0) do { s16x4 l0, l1, l2, l3, h0, h1, h2, h3; constexpr int b_ = VOFF + v_rd_off(d0, 0, 0); \
        TRRD(l0, b_); TRRD(h0, b_ + 2048); TRRD(l1, b_ + 4096); TRRD(h1, b_ + 6144); TRRD(l2, b_ + 8192); TRRD(h2, b_ + 10240); TRRD(l3, b_ + 12288); TRRD(h3, b_ + 14336); \
        asm volatile("s_waitcnt lgkmcnt(0)" ::: "memory"); SBAR(); \
        o[d0] = __builtin_amdgcn_mfma_f32_32x32x16_bf16(pa0, (bf16x8){l0[0], l0[1], l0[2], l0[3], h0[0], h0[1], h0[2], h0[3]}, o[d0], 0, 0, 0); \
        o[d0] = __builtin_amdgcn_mfma_f32_32x32x16_bf16(pa1, (bf16x8){l1[0], l1[1], l1[2], l1[3], h1[0], h1[1], h1[2], h1[3]}, o[d0], 0, 0, 0); \
        o[d0] = __builtin_amdgcn_mfma_f32_32x32x16_bf16(pa2, (bf16x8){l2[0], l2[1], l2[2], l2[3], h2[0], h2[1], h2[2], h2[3]}, o[d0], 0, 0, 0); \
        o[d0] = __builtin_amdgcn_mfma_f32_32x32x16_bf16(pa3, (bf16x8){l3[0], l3[1], l3[2], l3[3], h3[0], h3[1], h3[2], h3[3]}, o[d0], 0, 0, 0); } while (0)
    PV_D0(0); PV_D0(1); PV_D0(2); PV_D0(3);
#undef PV_D0
#undef TRRD
}

struct BgState { int cur, next, end, stride; };
struct BgSrc { unsigned char* ws; };
constexpr int BG_C0 = 32 * 128, BG_C1 = 64 * 128, BG_C2 = 64 * 128, BG_C3 = 64 * 512, BG_C4 = 256 * 128, BG_ND = BG_C0 + BG_C1 + BG_C2 + BG_C3 + BG_C4;
constexpr size_t WS_BGTAB = 512 * 1024;
__device__ __forceinline__ void bg_find(const BgSrc S_, int d, const float*& W, bf16*& WT, int& N, int& ldt, int& kb, int& nb, int& mi) {
    unsigned char* ws = S_.ws;
    int r = d, i = 0;
    if (r >= BG_C0) { r -= BG_C0; i = 1; if (r >= BG_C1) { r -= BG_C1; i = 2; if (r >= BG_C2) { r -= BG_C2; i = 3; if (r >= BG_C3) { r -= BG_C3; i = 4; } } } }
    { typedef const float* __attribute__((address_space(4))) * kptr_t;
      const int k = (i < 3) ? 16 + i : 17 + i;
      W = ((kptr_t)__builtin_amdgcn_kernarg_segment_ptr())[k]; }
    const size_t woff = (i == 0) ? WS_WAB : (i == 1) ? WS_WAB + 2048   : (i == 2) ? WS_WOUT : (i == 3) ? WS_WFF1 : WS_WFF2;
    WT = (bf16*)(ws + woff);
    N = (i == 3) ? DFF : DM; ldt = (i < 2) ? 6144 : (i == 4) ? DFF : DM; const int nblk = (i == 3) ? 512 : 128;
    kb = r / nblk; nb = r - kb * nblk; mi = i;
}
__device__ __forceinline__ void bg_issue(const BgSrc ws, int d, LAS unsigned char* buf, LAS unsigned char* sbuf, int lane) {
    const float* W; bf16* WT; int N, ldt, kb, nb, mi; bg_find(ws, d, W, WT, N, ldt, kb, nb, mi);
    const int kr = lane >> 3, c = lane & 7;
    const float* src = W + (size_t)(64 * kb + kr) * N + 32 * nb;
#pragma unroll
    for (int j = 0; j < 8; ++j)
        __builtin_amdgcn_global_load_lds((const unsigned*)(src + (size_t)(8 * j) * N + 4 * ((c ^ kr ^ j) & 7)), (LAS unsigned*)(buf + j * 1024), 16, 0, 0);
    if (mi <= 2 || (mi == 3 && nb < FF8 / 32)) {
        const float* st = (const float*)(ws.ws + (mi < 2 ? WS_CSAB : mi == 2 ? WS_CSO : WS_CSF)) + 32 * nb + lane;
        __builtin_amdgcn_global_load_lds((const unsigned*)st, (LAS unsigned*)sbuf, 4, 0, 0); }
}
__device__ __forceinline__ void bg_process(const BgSrc ws, int d, LAS unsigned char* buf, LAS unsigned char* sbuf, int lane) {
    const float* W; bf16* WT; int N, ldt, kb, nb, mi; bg_find(ws, d, W, WT, N, ldt, kb, nb, mi);
    const int q = lane & 7;
    if (mi <= 2 || (mi == 3 && nb < FF8 / 32)) {
        signed char* WQ = (signed char*)WT;
#pragma unroll
        for (int jj = 0; jj < 4; ++jj) { const int n = (lane >> 3) + 8 * jj; float v[8];
#pragma unroll
            for (int r = 0; r < 8; ++r) v[r] = *(const LAS float*)(buf + (((8 * q + r) * 8 + (((n >> 2) ^ r ^ q) & 7)) * 16 + (n & 3) * 4));
            { had_reg<8>(v);
#pragma unroll
                for (int r = 0; r < 8; ++r) { v[r] = had_x(v[r], 1, lane); v[r] = had_x(v[r], 2, lane); v[r] = had_x(v[r], 4, lane); } }
            const float st = *(const LAS float*)(sbuf + n * 4), inv = st > 0.f ? 1.0f / st : 0.f;
            unsigned qv[8];
#pragma unroll
            for (int r = 0; r < 8; ++r) qv[r] = __float_as_uint(__builtin_fmaf(v[r], inv, 12582912.0f));
            const unsigned a01 = __builtin_amdgcn_perm(qv[1], qv[0], 0x0c0c0400u), a23 = __builtin_amdgcn_perm(qv[3], qv[2], 0x0c0c0400u), a45 = __builtin_amdgcn_perm(qv[5], qv[4], 0x0c0c0400u), a67 = __builtin_amdgcn_perm(qv[7], qv[6], 0x0c0c0400u);
            *(v2u*)(WQ + (size_t)(32 * nb + n) * (mi < 2 ? 6144 : DM) + 64 * kb + 8 * q) = (v2u){__builtin_amdgcn_perm(a23, a01, 0x05040100u), __builtin_amdgcn_perm(a67, a45, 0x05040100u)}; }
        return; }
#pragma unroll
    for (int jj = 0; jj < 4; ++jj) { const int n = (lane >> 3) + 8 * jj; float v[8];
#pragma unroll
        for (int r = 0; r < 8; ++r) v[r] = *(const LAS float*)(buf + (((8 * q + r) * 8 + (((n >> 2) ^ r ^ q) & 7)) * 16 + (n & 3) * 4));
        *(v4u*)(WT + (size_t)(32 * nb + n) * ldt + 64 * kb + 8 * q) = (v4u){pg8::cvt_pk_bf16(v[0], v[1]), pg8::cvt_pk_bf16(v[2], v[3]), pg8::cvt_pk_bf16(v[4], v[5]), pg8::cvt_pk_bf16(v[6], v[7])}; }
}
__device__ __forceinline__ void bg_step(const BgSrc T, BgState& B, LAS unsigned char* buf, LAS unsigned char* sbuf, int lane) {
    asm volatile("" : "+v"(lane));
    if (B.cur >= 0) { VM_WAIT(); bg_process(T, B.cur, buf, sbuf, lane); B.cur = -1; }
    if (B.next < B.end) { LDS_WAIT(); bg_issue(T, B.next, buf, sbuf, lane); B.cur = B.next; B.next += B.stride; }
}

constexpr float ATT_THR = 11.5f;
constexpr int ATT_LDS_V = 0, ATT_LDS_K = 2 * SHM_V, ATT_LDS_WS = 2 * SHM_V + 2 * SHM_K;
__device__ __forceinline__ void attn_unit(int b, int h, int qb, const bf16* Q, const bf16* Kg, const bf16* Vg, bf16* AO, char* lds, const float* g_qn, const float* ROPE_C, const float* ROPE_S, const BgSrc BT, BgState& BS, LAS unsigned char* bgbuf, LAS unsigned char* bgsbuf, const int wid) {
    const int lane = pg8::lane_id(), tid = wid * 64 + lane, r32 = lane & 31, hi = lane >> 5;
    const int rowbase = b * SEQ, q0 = qb * 256, NT = (q0 + 256) / 64;
    char* V_lds = lds + ATT_LDS_V; char* K_lds = lds + ATT_LDS_K;
    float* ws = (float*)(lds + ATT_LDS_WS) + wid * 64; float* li_l = ws; float* al_l = ws + 32;
    const int kkey = tid >> 3, kpart = tid & 7;
    const char* Kbase = (const char*)(Kg + ((size_t)rowbase * NH + h) * QKH);
    unsigned koffb = (unsigned)(kkey * NH * QKH + kpart * 8) * 2u;
    const int kws = kkey * KPITCH + kpart * 16;
    const int sr = tid >> 4, sc = (tid & 15) * 8, vst0 = v_st(sr, sc), vst1 = v_st(32 + sr, sc);
    const char* Vbase = (const char*)(Vg + ((size_t)rowbase * NH + h) * VH);
    unsigned voffb = (unsigned)(sr * NH * VH + sc) * 2u;
    asm volatile("" : "+v"(koffb), "+v"(voffb));
    const int vb0 = (int)(uintptr_t)V_lds + v_rd_base(lane);
    const int qlo = q0 + wid * 32, qm = qlo + r32 - 4 * hi;
    bf16x8 qr[12];
    { const char* qbase = (const char*)(Q + ((size_t)(rowbase + qlo) * NH + h) * QKH); unsigned qoffb = (unsigned)(r32 * NH * QKH + hi * 8) * 2u; asm volatile("" : "+v"(qoffb));
#pragma unroll
      for (int d0 = 0; d0 < 12; ++d0) qr[d0] = *(const bf16x8*)(qbase + qoffb + d0 * 32); }
    { float ss = 0.f;
#pragma unroll
      for (int d0 = 0; d0 < 12; ++d0) { const v4u w = __builtin_bit_cast(v4u, qr[d0]);
#pragma unroll
          for (int e = 0; e < 4; ++e) { const float a = bflo(w[e]), b2 = bfhi(w[e]); ss += a * a + b2 * b2; } }
      { auto rr = __builtin_amdgcn_permlane32_swap(__float_as_uint(ss), __float_as_uint(ss), false, false); ss = __uint_as_float(rr[0]) + __uint_as_float(rr[1]); }
      const float rs = QSCALE / sqrtf(ss * (1.0f / 192.0f) + EPS);
      unsigned goff = (unsigned)hi * 32u, roff = (unsigned)(r32 * 32 + hi * 8) * 4u;
      asm volatile("" : "+v"(goff), "+v"(roff));
      const float* gq = (const float*)((const char*)g_qn + goff);
#pragma unroll
      for (int d0 = 0; d0 < 8; ++d0) { const v4u w = __builtin_bit_cast(v4u, qr[d0]); const f32x4 g0 = *(const f32x4*)(gq + d0 * 16), g1 = *(const f32x4*)(gq + d0 * 16 + 4);
          const v4u o = {pk2(bflo(w[0]) * rs * g0[0], bfhi(w[0]) * rs * g0[1]), pk2(bflo(w[1]) * rs * g0[2], bfhi(w[1]) * rs * g0[3]),
                         pk2(bflo(w[2]) * rs * g1[0], bfhi(w[2]) * rs * g1[1]), pk2(bflo(w[3]) * rs * g1[2], bfhi(w[3]) * rs * g1[3])};
          qr[d0] = __builtin_bit_cast(bf16x8, o); }
      const float* cs = (const float*)((const char*)(ROPE_C + (size_t)(rowbase + qlo) * 32) + roff); const float* sn = (const float*)((const char*)(ROPE_S + (size_t)(rowbase + qlo) * 32) + roff);
#pragma unroll
      for (int d0 = 8; d0 < 10; ++d0) { const v4u wa = __builtin_bit_cast(v4u, qr[d0]), wb = __builtin_bit_cast(v4u, qr[d0 + 2]);
          const f32x4 g0 = *(const f32x4*)(gq + d0 * 16), g1 = *(const f32x4*)(gq + d0 * 16 + 4), h0 = *(const f32x4*)(gq + d0 * 16 + 32), h1 = *(const f32x4*)(gq + d0 * 16 + 36);
          const f32x4 c0 = *(const f32x4*)(cs + (d0 - 8) * 16), c1 = *(const f32x4*)(cs + (d0 - 8) * 16 + 4), s0 = *(const f32x4*)(sn + (d0 - 8) * 16), s1 = *(const f32x4*)(sn + (d0 - 8) * 16 + 4);
          float a[8], bq[8];
#pragma unroll
          for (int e = 0; e < 4; ++e) { a[2 * e] = bflo(wa[e]) * rs; a[2 * e + 1] = bfhi(wa[e]) * rs; bq[2 * e] = bflo(wb[e]) * rs; bq[2 * e + 1] = bfhi(wb[e]) * rs; }
#pragma unroll
          for (int e = 0; e < 4; ++e) { a[e] *= g0[e]; a[4 + e] *= g1[e]; bq[e] *= h0[e]; bq[4 + e] *= h1[e]; }
#pragma unroll
          for (int e = 0; e < 8; ++e) { const float c_ = e < 4 ? c0[e] : c1[e - 4], s_ = e < 4 ? s0[e] : s1[e - 4]; const float x1 = a[e], x2 = bq[e]; a[e] = x1 * c_ - x2 * s_; bq[e] = x2 * c_ + x1 * s_; }
          const v4u oa = {pk2(a[0], a[1]), pk2(a[2], a[3]), pk2(a[4], a[5]), pk2(a[6], a[7])}, ob = {pk2(bq[0], bq[1]), pk2(bq[2], bq[3]), pk2(bq[4], bq[5]), pk2(bq[6], bq[7])};
          qr[d0] = __builtin_bit_cast(bf16x8, oa); qr[d0 + 2] = __builtin_bit_cast(bf16x8, ob); } }
    bf16x8 sk0, sk1, sk2, sv0, sv1;
#define A_SLOAD(t) do { const char* kp_ = Kbase + (size_t)(t) * (64 * NH * QKH * 2); sk0 = *(const bf16x8*)(kp_ + koffb); sk1 = *(const bf16x8*)(kp_ + koffb + 128); sk2 = *(const bf16x8*)(kp_ + koffb + 256); \
        const char* vp_ = Vbase + (size_t)(t) * (64 * NH * VH * 2); sv0 = *(const bf16x8*)(vp_ + voffb); sv1 = *(const bf16x8*)(vp_ + voffb + 32 * NH * VH * 2); } while (0)
#define A_SWRITE(bf) do { char* kd_ = K_lds + (bf) * SHM_K + kws; *(bf16x8*)kd_ = sk0; *(bf16x8*)(kd_ + 128) = sk1; *(bf16x8*)(kd_ + 256) = sk2; \
        *(bf16x8*)(V_lds + (bf) * SHM_V + vst0) = sv0; *(bf16x8*)(V_lds + (bf) * SHM_V + vst1) = sv1; } while (0)
    float m_reg = -1e30f, l_reg = 0.f; f32x16 o[4] = {};
    A_SLOAD(0); VM_WAIT(); A_SWRITE(0); LDS_WAIT(); __syncthreads();
    const char* kb0 = K_lds + r32 * KPITCH + hi * 16;
#define A_STEP(t, BF) do { \
        if ((t) + 1 < NT) A_SLOAD((t) + 1); \
        if ((t) * 64 <= qlo + 31) {   \
        f32x16 p0 = {}, p1 = {}; \
        _Pragma("unroll") for (int d0 = 0; d0 < 12; ++d0) { const char* a_ = kb0 + (BF) * SHM_K + d0 * 32; \
            const bf16x8 k0_ = *(const bf16x8*)a_; const bf16x8 k1_ = *(const bf16x8*)(a_ + 32 * KPITCH); \
            p0 = __builtin_amdgcn_mfma_f32_32x32x16_bf16(k0_, qr[d0], p0, 0, 0, 0); p1 = __builtin_amdgcn_mfma_f32_32x32x16_bf16(k1_, qr[d0], p1, 0, 0, 0); if (d0 % 2 == 1) SBAR(); } \
        { const int kbase_ = (t) * 64; if (kbase_ + 63 > qlo) { const int dq_ = qm - kbase_; const float NEG_ = -__builtin_inff(); \
            _Pragma("unroll") for (int r = 0; r < 16; ++r) { const int c_ = (r & 3) + 8 * (r >> 2); if (dq_ - c_ < 0) p0[r] = NEG_; if (dq_ - c_ - 32 < 0) p1[r] = NEG_; } } } \
        float pmax_ = p0[0]; _Pragma("unroll") for (int r = 1; r < 16; ++r) pmax_ = fmaxf(pmax_, p0[r]); _Pragma("unroll") for (int r = 0; r < 16; ++r) pmax_ = fmaxf(pmax_, p1[r]); \
        { auto rr_ = __builtin_amdgcn_permlane32_swap(__float_as_uint(pmax_), __float_as_uint(pmax_), false, false); pmax_ = fmaxf(__uint_as_float(rr_[0]), __uint_as_float(rr_[1])); } \
        float mn_, alpha_; \
        if (__all(pmax_ - m_reg <= ATT_THR)) { mn_ = m_reg; alpha_ = 1.f; } else { mn_ = fmaxf(m_reg, pmax_); alpha_ = __builtin_amdgcn_exp2f(m_reg - mn_); m_reg = mn_; } \
        _Pragma("unroll") for (int r = 0; r < 16; ++r) { p0[r] = __builtin_amdgcn_exp2f(p0[r] - mn_); p1[r] = __builtin_amdgcn_exp2f(p1[r] - mn_); } \
        float ps_ = 0.f; _Pragma("unroll") for (int r = 0; r < 16; ++r) ps_ += p0[r]; _Pragma("unroll") for (int r = 0; r < 16; ++r) ps_ += p1[r]; \
        { auto rr_ = __builtin_amdgcn_permlane32_swap(__float_as_uint(ps_), __float_as_uint(ps_), false, false); ps_ = __uint_as_float(rr_[0]) + __uint_as_float(rr_[1]); } \
        l_reg = l_reg * alpha_ + ps_; \
        bf16x8 pa0_, pa1_, pa2_, pa3_; \
        A_PK4(p0, 0, pa0_); A_PK4(p0, 8, pa1_); A_PK4(p1, 0, pa2_); A_PK4(p1, 8, pa3_); \
        if (__any(alpha_ < 1.f)) { if (hi == 0) al_l[r32] = alpha_; LDS_WAIT(); \
            _Pragma("unroll") for (int d_ = 0; d_ < 4; ++d_) _Pragma("unroll") for (int r = 0; r < 16; ++r) o[d_][r] *= al_l[crow(r, hi)]; } \
        SBAR(); pv_tile<(BF) * SHM_V>(o, vb0, pa0_, pa1_, pa2_, pa3_); } \
        if ((t) + 1 < NT) { VM_WAIT(); A_SWRITE(1 - (BF)); } \
        bg_step(BT, BS, bgbuf, bgsbuf, lane);   \
        LDS_WAIT(); __syncthreads(); } while (0)
#define A_PK4(P, B_, OUT) do { unsigned a0_ = cvtpk(P[B_ + 0], P[B_ + 1]), a1_ = cvtpk(P[B_ + 2], P[B_ + 3]), b0_ = cvtpk(P[B_ + 4], P[B_ + 5]), b1_ = cvtpk(P[B_ + 6], P[B_ + 7]); \
        auto r0_ = __builtin_amdgcn_permlane32_swap(a0_, b0_, false, false); auto r1_ = __builtin_amdgcn_permlane32_swap(a1_, b1_, false, false); \
        v4u w_ = {r0_[0], r1_[0], r0_[1], r1_[1]}; OUT = __builtin_bit_cast(bf16x8, w_); } while (0)
    asm volatile(".p2align 6\n\ts_nop 0\n\ts_nop 0\n\ts_nop 0\n\ts_nop 0\n\ts_nop 0\n\ts_nop 0\n\ts_nop 0\n\ts_nop 0\n\ts_nop 0\n\ts_nop 0\n\ts_nop 0\n\ts_nop 0\n\ts_nop 0\n\ts_nop 0");
    for (int t = 0; t < NT; t += 2) { A_STEP(t, 0); asm volatile(".p2align 6\n\ts_nop 0\n\ts_nop 0\n\ts_nop 0\n\ts_nop 0\n\ts_nop 0\n\ts_nop 0\n\ts_nop 0\n\ts_nop 0\n\ts_nop 0\n\ts_nop 0\n\ts_nop 0\n\ts_nop 0\n\ts_nop 0\n\ts_nop 0"); A_STEP(t + 1, 1); }
#undef A_STEP
#undef A_PK4
#undef A_SLOAD
#undef A_SWRITE
    if (hi == 0) li_l[r32] = l_reg; LDS_WAIT();
    char* Ow = (char*)(AO + (size_t)(rowbase + qlo) * 6144 + 2048 + h * VH);
    unsigned ooffb = (unsigned)(4 * hi * 6144 + r32) * 2u; asm volatile("" : "+v"(ooffb));
#pragma unroll
    for (int r = 0; r < 16; ++r) { const int orow = crow(r, hi); const float rl = __builtin_amdgcn_rcpf(li_l[orow]);
#pragma unroll
        for (int d0 = 0; d0 < 4; ++d0) { const float v = o[d0][r] * rl; const float vn = __shfl_xor(v, 1);
            if ((r32 & 1) == 0) *(unsigned*)(Ow + ooffb + (((r & 3) + 8 * (r >> 2)) * 6144 + d0 * 32) * 2) = cvtpk(v, vn); } }
    LDS_WAIT(); __syncthreads();
}

__device__ __forceinline__ void gmlp_unit(int b, int n, int g, const bf16* UV, const float* rv, const float* w_s, const float* b_s, const float* g_v, bf16* AO, char* lds, const int wid) {
    const int lane = pg8::lane_id(), tid = wid * 64 + lane, r32 = lane & 31, hi = lane >> 5;
    const int wt = wid & 3, wh = wid >> 2, R0 = b * SEQ + n * 128, C0 = g * 256;
    { const int sr = tid >> 4, sc = (tid & 15) * 8, vst0 = v_st(sr, sc), vst1 = v_st(32 + sr, sc);
      bf16x8 tv[8];
#pragma unroll
      for (int sh = 0; sh < 2; ++sh)
#pragma unroll
          for (int ch = 0; ch < 2; ++ch) { const bf16* p = UV + (size_t)(R0 + sh * 64 + sr) * 4096 + 2048 + C0 + ch * 128 + sc;
              tv[(sh * 2 + ch) * 2] = *(const bf16x8*)p; tv[(sh * 2 + ch) * 2 + 1] = *(const bf16x8*)(p + (size_t)32 * 4096); }
#pragma unroll
      for (int i = 0; i < 4; ++i) { *(bf16x8*)(lds + i * SHM_V + vst0) = tv[2 * i]; *(bf16x8*)(lds + i * SHM_V + vst1) = tv[2 * i + 1]; } }
    LDS_WAIT(); __syncthreads();
    f32x16 o[4] = {};
    const int vb0 = (int)(uintptr_t)lds + wh * SHM_V + v_rd_base(lane);
    const int t = wt * 32 + r32;
    const float* wrow = w_s + ((size_t)g * 128 + t) * 128;
#define G_FRAG(ks, OUT) do { const int s0_ = (ks) * 16 + hi * 8; const f32x4 wa_ = *(const f32x4*)(wrow + s0_), wb_ = *(const f32x4*)(wrow + s0_ + 4); \
        const f32x4 ra_ = *(const f32x4*)(rv + R0 + s0_), rb_ = *(const f32x4*)(rv + R0 + s0_ + 4); float e_[8]; \
        _Pragma("unroll") for (int j = 0; j < 4; ++j) { e_[j] = (s0_ + j <= t) ? wa_[j] * ra_[j] : 0.f; e_[4 + j] = (s0_ + 4 + j <= t) ? wb_[j] * rb_[j] : 0.f; } \
        v4u w_ = {cvtpk(e_[0], e_[1]), cvtpk(e_[2], e_[3]), cvtpk(e_[4], e_[5]), cvtpk(e_[6], e_[7])}; OUT = __builtin_bit_cast(bf16x8, w_); } while (0)
    { bf16x8 pa0, pa1, pa2, pa3; G_FRAG(0, pa0); G_FRAG(1, pa1); G_FRAG(2, pa2); G_FRAG(3, pa3); SBAR(); pv_tile<0>(o, vb0, pa0, pa1, pa2, pa3); }
    if (wt >= 2) { bf16x8 pa0, pa1, pa2, pa3; G_FRAG(4, pa0); G_FRAG(5, pa1); G_FRAG(6, pa2); G_FRAG(7, pa3); SBAR(); pv_tile<2 * SHM_V>(o, vb0, pa0, pa1, pa2, pa3); }
#undef G_FRAG
#pragma unroll
    for (int d0 = 0; d0 < 4; ++d0) { const int c = C0 + wh * 128 + d0 * 32 + r32; const float gv = g_v[c];
#pragma unroll
        for (int r = 0; r < 16; ++r) { const int tr = wt * 32 + crow(r, hi); const size_t row = (size_t)(R0 + tr);
            const float u = __uint_as_float((unsigned)UV[row * 4096 + c] << 16);
            const float v = u * (gv * o[d0][r] + b_s[g * 128 + tr]); const float vn = __shfl_xor(v, 1);
            if ((r32 & 1) == 0) *(unsigned*)(AO + row * 6144 + c) = cvtpk(v, vn); } }
    LDS_WAIT(); __syncthreads();
}

__device__ __forceinline__ void head_norm_rope(v4u (&w)[12], int half, const float* gain, const float* cs, const float* sn, float scale) {
    float ss = 0.f;
#pragma unroll
    for (int j = 0; j < 12; ++j)
#pragma unroll
        for (int e = 0; e < 4; ++e) { const float a = bflo(w[j][e]), b2 = bfhi(w[j][e]); ss += a * a + b2 * b2; }
    ss += __shfl_xor(ss, 1);
    const float rs = scale / sqrtf(ss * (1.0f / 192.0f) + EPS);
    const float* gp = gain + half * 96;
#pragma unroll
    for (int j = 0; j < 4; ++j) {
        const f32x4 g0 = *(const f32x4*)(gp + 8 * j), g1 = *(const f32x4*)(gp + 8 * j + 4);
        w[j] = (v4u){pk2(bflo(w[j][0]) * rs * g0[0], bfhi(w[j][0]) * rs * g0[1]), pk2(bflo(w[j][1]) * rs * g0[2], bfhi(w[j][1]) * rs * g0[3]),
                     pk2(bflo(w[j][2]) * rs * g1[0], bfhi(w[j][2]) * rs * g1[1]), pk2(bflo(w[j][3]) * rs * g1[2], bfhi(w[j][3]) * rs * g1[3])};
    }
#pragma unroll
    for (int j = 4; j < 8; ++j) {
        float a[8], b[8];
        { const f32x4 g0 = *(const f32x4*)(gp + 8 * j), g1 = *(const f32x4*)(gp + 8 * j + 4), h0 = *(const f32x4*)(gp + 8 * j + 32), h1 = *(const f32x4*)(gp + 8 * j + 36);
#pragma unroll
          for (int e = 0; e < 4; ++e) { a[2 * e] = bflo(w[j][e]) * rs; a[2 * e + 1] = bfhi(w[j][e]) * rs; b[2 * e] = bflo(w[j + 4][e]) * rs; b[2 * e + 1] = bfhi(w[j + 4][e]) * rs; }
#pragma unroll
          for (int e = 0; e < 4; ++e) { a[e] *= g0[e]; a[4 + e] *= g1[e]; b[e] *= h0[e]; b[4 + e] *= h1[e]; } }
        if (half) {
            const f32x4 c0 = *(const f32x4*)(cs + 8 * (j - 4)), c1 = *(const f32x4*)(cs + 8 * (j - 4) + 4), s0 = *(const f32x4*)(sn + 8 * (j - 4)), s1 = *(const f32x4*)(sn + 8 * (j - 4) + 4);
#pragma unroll
            for (int e = 0; e < 8; ++e) { const float c_ = e < 4 ? c0[e] : c1[e - 4], s_ = e < 4 ? s0[e] : s1[e - 4]; const float x1 = a[e], x2 = b[e]; a[e] = x1 * c_ - x2 * s_; b[e] = x2 * c_ + x1 * s_; }
        }
        w[j] = (v4u){pk2(a[0], a[1]), pk2(a[2], a[3]), pk2(a[4], a[5]), pk2(a[6], a[7])};
        w[j + 4] = (v4u){pk2(b[0], b[1]), pk2(b[2], b[3]), pk2(b[4], b[5]), pk2(b[6], b[7])};
    }
}

__global__ void __launch_bounds__(NWAVES * 64, 2) hybrid_fwd(Args args) {
    extern __shared__ __attribute__((aligned(16))) unsigned char lds[];
    Frame F;
    F.lds = (LAS unsigned char*)lds;
    F.wave = __builtin_amdgcn_readfirstlane((int)threadIdx.x >> 6);
#define FTID (F.wave * 64 + pg8::lane_id())
    F.G = gridDim.x; { const int bx = blockIdx.x; F.vcu = (F.G % 8 == 0) ? (bx % 8) * (F.G / 8) + bx / 8 : bx; }
    unsigned char* ws = args.ws;
    gu32* ctl = (gu32*)(ws + WS_CTL);
    volatile LAS unsigned* MISC = (volatile LAS unsigned*)(F.lds + MISC_OFF);
    for (int u = FTID; u < (LDS_BYTES - LDSCTL_OFF) / 4; u += NWAVES * 64) ((LAS unsigned*)(F.lds + LDSCTL_OFF))[u] = 0u;
    __syncthreads();
    XcdBarrier bar; bar.bar = (unsigned*)(ctl + CW_BAR); bar.x = 0; bar.st = nullptr; bar.wave = F.wave;
    if (MK_N_LAUNCHES == 1) bar = xcd_barrier_post((unsigned*)(ctl + CW_BAR), MISC + 8, F.wave);
#define GRID_BAR() do { if (MK_N_LAUNCHES == 1) xcd_barrier(bar); } while (0)
    const int lo = args.ph_lo, hi_ph = args.ph_hi;
#define IN(k) (lo <= (k) && (k) < hi_ph && !(DIAG_STOP >= 0 && (k) > DIAG_STOP && (k) < 12))
#define BOTH(k) (IN(k) && IN((k) + 1))

    const float* x = args.in[0]; const float* cnd = args.in[1]; const int* positions = (const int*)args.in[2];
    const float* w_ada = args.in[3]; const float* b_ada = args.in[4]; const float* g_norm1 = args.in[5]; const float* w_in = args.in[6];
    const float* g_v = args.in[7]; const float* w_s = args.in[8]; const float* b_s = args.in[9]; const float* g_q_lat = args.in[10]; const float* g_kv_lat = args.in[11];
    const float* w_uq = args.in[12]; const float* w_ukv = args.in[13]; const float* g_qn = args.in[14]; const float* g_kn = args.in[15];
    const float* w_ba = args.in[16]; const float* w_bb = args.in[17]; const float* w_out = args.in[18]; const float* g_norm2 = args.in[19];
    const float* w_ff1 = args.in[20]; const float* w_ff2 = args.in[21];
    float* out = args.out;
    float* MOD = (float*)(ws + WS_MOD); float* RV = (float*)(ws + WS_STATS); float* RQ = RV + M; float* RKV = RQ + M;
    float* RPE = RKV + M; float* PER = (float*)(ws + WS_MODP);     float* ROPE_C = (float*)(ws + WS_ROPE); float* ROPE_S = ROPE_C + (size_t)M * 32; float* MODP = (float*)(ws + WS_MODP);
    bf16* WIN_T = (bf16*)(ws + WS_WIN); bf16* WUQ_T = (bf16*)(ws + WS_WUQ); bf16* WUKV_T = (bf16*)(ws + WS_WUKV); bf16* WAB_T = (bf16*)(ws + WS_WAB);
    bf16* WOUT_T = (bf16*)(ws + WS_WOUT); bf16* WFF1_T = (bf16*)(ws + WS_WFF1); bf16* WFF2_T = (bf16*)(ws + WS_WFF2);
    bf16* HB = (bf16*)(ws + WS_H); bf16* UV = (bf16*)(ws + WS_UV); bf16* QL = (bf16*)(ws + WS_QL); bf16* KVL = (bf16*)(ws + WS_KVL); bf16* KPE = (bf16*)(ws + WS_KPE);
    bf16* GATES = (bf16*)(ws + WS_GATES); bf16* AO = (bf16*)(ws + WS_AO); bf16* QB = (bf16*)(ws + WS_Q); bf16* KN = (bf16*)(ws + WS_KN); bf16* VB = (bf16*)(ws + WS_V);
    bf16* KB = (bf16*)(ws + WS_K); bf16* MIXED = (bf16*)(ws + WS_MIXED); float* TB = (float*)(ws + WS_T); bf16* F1 = (bf16*)(ws + WS_F1);
    signed char* WOUT8 = (signed char*)(ws + WS_WOUT); signed char* M8 = (signed char*)(ws + WS_M8); float* MSTEP = (float*)(ws + WS_MS); float* CSO = (float*)(ws + WS_CSO); float* CMAXO = (float*)(ws + WS_CMAXO);
    signed char* WG8 = (signed char*)(ws + WS_WG8); signed char* H8 = (signed char*)(ws + WS_H8); float* CMAXP = (float*)(ws + WS_CMAXP); float* CSTEP = (float*)(ws + WS_CS); float* HSTEP = (float*)(ws + WS_HS);
    float* CMAXAB = (float*)(ws + WS_CMAXAB); float* CSAB = (float*)(ws + WS_CSAB); float* SA = (float*)(ws + WS_SA); float* SB = (float*)(ws + WS_SB); signed char* A8 = (signed char*)(ws + WS_A8); signed char* WAB8 = (signed char*)(ws + WS_WAB);
    float* CMAXF = (float*)(ws + WS_CMAXF); float* CSF = (float*)(ws + WS_CSF); signed char* H28 = (signed char*)(ws + WS_H8); signed char* WFF18 = (signed char*)(ws + WS_WFF1);
    const int gw = F.vcu * NWAVES + F.wave, NGW = F.G * NWAVES;

    if (IN(0)) {
        const int ptid = FTID, plane = ptid & 63;
        LAS float* scr = (LAS float*)(F.lds + F.wave * 16384);
        for (int it = gw; it < KSPLIT * 96; it += NGW) {
            const int kc = it / 96, nc = it % 96, k0 = kc * KCH, n0 = nc * 256 + 4 * plane;
#pragma unroll
            for (int j = 0; j < 8; ++j) { const int idx = plane + 64 * j, bb = idx >> 7, kk = idx & 127; const float cv = cnd[bb * DM + k0 + kk]; scr[idx] = cv / (1.0f + __expf(-cv)); }
            LDS_WAIT(); asm volatile("" ::: "memory");
            f32x4 a0 = {0.f, 0.f, 0.f, 0.f}, a1 = a0, a2 = a0, a3 = a0;
            const float* wp = w_ada + (size_t)k0 * NMODC + n0;
#pragma unroll 8
            for (int kk = 0; kk < KCH; ++kk) { const f32x4 w = __builtin_nontemporal_load((const f32x4*)(wp + (size_t)kk * NMODC));
                a0 += w * scr[kk]; a1 += w * scr[128 + kk]; a2 += w * scr[256 + kk]; a3 += w * scr[384 + kk]; }
            float* mp = MODP + (size_t)(kc * 4) * NMODC + n0;
            *(f32x4*)mp = a0; *(f32x4*)(mp + NMODC) = a1; *(f32x4*)(mp + 2 * NMODC) = a2; *(f32x4*)(mp + 3 * NMODC) = a3;
            LDS_WAIT(); asm volatile("" ::: "memory");
        }
        constexpr int NBF = UV8 ? 50 : 178, I_IN = 64 * NBF, I_UQ = 16 * 192, I_UKV = 8 * 256;
        constexpr int NITEMS = I_IN + I_UQ + I_UKV;
        for (int it = gw; it < NITEMS; it += NGW) {
            int r = it;
            if (r < I_IN) { const int kb = r / NBF, nb = (UV8 ? 128 : 0) + r % NBF; p0_transpose_item(w_in, IN_COLS, WIN_T, DM, 0, nullptr, scr, kb, nb, plane); continue; } r -= I_IN;
            if (r < I_UQ) { p0_transpose_item(w_uq, 6144, WUQ_T, QLORA, 0, g_q_lat, scr, r / 192, r % 192, plane); continue; } r -= I_UQ;
            p0_transpose_item(w_ukv, 8192, WUKV_T, KVLORA, 0, g_kv_lat, scr, r / 256, r % 256, plane);
        }
        for (int it = gw; it < 64 * 64; it += NGW) { const int kb = it >> 6, nc = it & 63;
            CMAXO[(size_t)kb * DM + nc * 64 + plane] = rot_colmax64<true>(w_out + (size_t)(kb * 64) * DM + nc * 64 + plane, DM); }
        for (int it = gw; it < 64 * (FF8 / 64); it += NGW) { const int kb = it / (FF8 / 64), nc = it % (FF8 / 64);
            const float* wp = w_ff1 + (size_t)(kb * 64) * DFF + nc * 64 + plane;
            float w[64];
#pragma unroll
            for (int kk = 0; kk < 64; ++kk) w[kk] = __builtin_nontemporal_load(wp + (size_t)kk * DFF);
            had_reg<64>(w);
            float mx = 0.f;
#pragma unroll
            for (int kk = 0; kk < 64; ++kk) mx = fmaxf(mx, fabsf(w[kk]));
            CMAXF[(size_t)kb * DFF + nc * 64 + plane] = mx; }
        for (int it = gw; it < 96 * 64; it += NGW) { const int kb = it >> 6, nc = it & 63;
            const float* wp = (kb < 32 ? w_ba + (size_t)(kb * 64) * DM : w_bb + (size_t)((kb - 32) * 64) * DM) + nc * 64 + plane;
            float w[64];
#pragma unroll
            for (int kk = 0; kk < 64; ++kk) w[kk] = __builtin_nontemporal_load(wp + (size_t)kk * DM);
            had_reg<64>(w);
            float mx = 0.f;
#pragma unroll
            for (int kk = 0; kk < 64; ++kk) mx = fmaxf(mx, fabsf(w[kk]));
            CMAXAB[(size_t)kb * DM + nc * 64 + plane] = mx; }
        for (int i = gw * 64 + plane; i < 192 * 512; i += NGW * 64) *(v4u*)(WIN_T + (size_t)OFF_GATE * DM + (size_t)i * 8) = (v4u){0u, 0u, 0u, 0u};
        for (int i = gw * 64 + plane; i < M * 32; i += NGW * 64) { const int row = i >> 5, fi = i & 31; const float ang = (float)positions[row] * args.inv_freq[fi];
            float c_, s_; sincos_acc(ang, c_, s_); ROPE_C[i] = c_; ROPE_S[i] = s_; }
        for (int it = gw; it < 64 * (NQ8 / 64); it += NGW) { const int kb = it / (NQ8 / 64), nc = it % (NQ8 / 64), scol = nc * 64 + (nc >= UV8 / 64 ? OFF_GATE - UV8 : 0);
            CMAXP[(size_t)kb * NQ8 + nc * 64 + plane] = rot_colmax64(w_in + (size_t)(kb * 64) * IN_COLS + scol + plane, IN_COLS); }
        if (BOTH(0)) GRID_BAR();
    }

    if (IN(1)) {
        const int ptid = FTID, plane = ptid & 63;
        for (int wgi = blockIdx.x; wgi < M / 32; wgi += F.G) {
            if (ptid < 384) { const int idx = wgi * 384 + ptid, b2 = idx / NMODC, n = idx % NMODC; const float* mp = MODP + (size_t)b2 * NMODC + n;
                float pv_[KSPLIT];
#pragma unroll
                for (int kc = 0; kc < KSPLIT; ++kc) pv_[kc] = mp[(size_t)kc * 4 * NMODC];
                float s_ = b_ada[n];
#pragma unroll
                for (int kc = 0; kc < KSPLIT; ++kc) s_ += pv_[kc];
                MOD[idx] = s_; }
            if (ptid < NQ8 / 256) { const int n = wgi * (NQ8 / 256) + ptid; float mx = 0.f;
#pragma unroll
                for (int kc = 0; kc < 64; ++kc) mx = fmaxf(mx, CMAXP[(size_t)kc * NQ8 + n]);
                CSTEP[n] = mx * (1.0f / 127.0f); }
            if (ptid >= 64 && ptid < 80) { const int n = wgi * 16 + (ptid - 64); float mx = 0.f;
#pragma unroll
                for (int kc = 0; kc < 64; ++kc) mx = fmaxf(mx, CMAXO[(size_t)kc * DM + n]);
                CSO[n] = mx * (1.0f / 127.0f); }
            if (ptid >= 192 && ptid < 208) { const int n = wgi * 16 + (ptid - 192); float mx = 0.f;
#pragma unroll 8
                for (int kc = 0; kc < 96; ++kc) mx = fmaxf(mx, CMAXAB[(size_t)kc * DM + n]);
                CSAB[n] = mx * (1.0f / 127.0f); }
            if (ptid >= 128 && ptid < 192 && wgi * 64 < FF8) { const int n = wgi * 64 + (ptid - 128); float mx = 0.f;
#pragma unroll
                for (int kc = 0; kc < 64; ++kc) mx = fmaxf(mx, CMAXF[(size_t)kc * DFF + n]);
                CSF[n] = mx * (1.0f / 127.0f); }
        }
        GRID_BAR();
        { LAS float* scr = (LAS float*)(F.lds + F.wave * 16384);
          for (int it = gw; it < 64 * (NQ8 / 32); it += NGW) { const int kb = it / (NQ8 / 32), nb = it % (NQ8 / 32);
              quant_transpose_item(w_in + (nb >= UV8 / 32 ? OFF_GATE - UV8 : 0), IN_COLS, WG8, DM, CSTEP, scr, kb, nb, pg8::lane_id()); }
        }
        LDS_WAIT(); __syncthreads();
        LAS float* modl = (LAS float*)F.lds;
        for (int wgi = blockIdx.x; wgi < M / 32; wgi += F.G) {
            const int bb = wgi >> 6; const float* mb = MOD + (size_t)bb * NMODC;
#pragma unroll
            for (int j = 0; j < 2; ++j) { const int col = 4 * (ptid + 512 * j); const f32x4 g4 = *(const f32x4*)(g_norm1 + col), sh = *(const f32x4*)(mb + col), sc = *(const f32x4*)(mb + DM + col);
                *(LAS f32x4*)(modl + col) = g4 * (sc + 1.0f); *(LAS f32x4*)(modl + DM + col) = sh; }
            LDS_WAIT(); __syncthreads();
#pragma unroll 1
            for (int i = 0; i < 4; ++i) { const int row = wgi * 32 + F.wave * 4 + i; const int pl = pg8::lane_id();
                const f32x4* xr = (const f32x4*)(x + (size_t)row * DM) + pl;
                f32x4 v[16]; float ss = 0.f;
#pragma unroll
                for (int j = 0; j < 16; ++j) { v[j] = xr[64 * j]; ss += (v[j].x * v[j].x + v[j].y * v[j].y) + (v[j].z * v[j].z + v[j].w * v[j].w); }
                const float r = 1.0f / sqrtf(wave_sum(ss) * (1.0f / DM) + EPS);
                float hm = 0.f;
#pragma unroll
                for (int j = 0; j < 16; ++j) { const int col = 4 * (pl + 64 * j);
                    const f32x4 ga = *(const LAS f32x4*)(modl + col), sh = *(const LAS f32x4*)(modl + DM + col);
                    const f32x4 hv = v[j] * r * ga + sh; v[j] = hv;
                    *(v2u*)(HB + (size_t)row * DM + col) = (v2u){pk2(hv.x, hv.y), pk2(hv.z, hv.w)}; }
#pragma unroll
                for (int j = 0; j < 16; ++j) { f32x4 t = had4(v[j]);
#pragma unroll
                    for (int e = 0; e < 4; ++e) { float x_ = t[e]; x_ = had_x(x_, 1, pl); x_ = had_x(x_, 2, pl); x_ = had_x(x_, 4, pl); x_ = had_x(x_, 8, pl); t[e] = x_; }
                    v[j] = t; hm = fmaxf(fmaxf(hm, fmaxf(fabsf(t.x), fabsf(t.y))), fmaxf(fabsf(t.z), fabsf(t.w))); }
#pragma unroll
                for (int o_ = 1; o_ < 64; o_ <<= 1) hm = fmaxf(hm, __shfl_xor(hm, o_));
                const float inv = hm > 0.f ? 127.0f / hm : 0.f;
                if (pl == 0) HSTEP[row] = hm * (1.0f / (127.0f * 64.0f));
#pragma unroll
                for (int j = 0; j < 16; ++j) { const int col = 4 * (pl + 64 * j);
                    const unsigned q0 = __float_as_uint(__builtin_fmaf(v[j].x, inv, 12582912.0f)), q1 = __float_as_uint(__builtin_fmaf(v[j].y, inv, 12582912.0f)), q2 = __float_as_uint(__builtin_fmaf(v[j].z, inv, 12582912.0f)), q3 = __float_as_uint(__builtin_fmaf(v[j].w, inv, 12582912.0f));
                    *(unsigned*)(H8 + (size_t)row * DM + col) = __builtin_amdgcn_perm(__builtin_amdgcn_perm(q3, q2, 0x0c0c0400u), __builtin_amdgcn_perm(q1, q0, 0x0c0c0400u), 0x05040100u); } }
            LDS_WAIT(); __syncthreads();
        }
        if (BOTH(1)) GRID_BAR();
    }

    if (IN(2)) {
        const int ptid = FTID, plane = ptid & 63;
        { pg8::Gemm g{HB, WIN_T + (size_t)UV8 * DM, DM, DM, M, NP_GATE - UV8, DM}; pg8::StaticOrder S; S.init(M, NP_GATE - UV8, F.G, (int)blockIdx.x);
          pg8::EpiProj E{UV, QL, KVL, KPE, GATES, UV8 / 256};
          pg8::gemm_phase<pg8::EpiProj, pg8::StaticOrder>(F.lds, g, S, E, F.wave); }
        { pg8::Gemm g{(const bf16*)H8, (const bf16*)WG8, DM / 2, DM / 2, M, NQ8, DM / 2}; pg8::StaticOrder S; S.init(M, NQ8, F.G, (int)blockIdx.x);
          pg8::EpiGateI8 E{UV, GATES, HSTEP, CSTEP};
          pg8::gemm_phase<pg8::EpiGateI8, pg8::StaticOrder, PG8_ALIGN, PG8_SP2, true>(F.lds, g, S, E, F.wave); }
        if (BOTH(2)) GRID_BAR();
    }

    if (IN(3)) {
        const int ptid = FTID, plane = ptid & 63;
        for (int row = gw; row < M; row += NGW) {
            float sv = 0.f, sq = 0.f, sk = 0.f;
            const v4u* pv_ = (const v4u*)(UV + (size_t)row * 4096 + 2048) + plane;
#pragma unroll
            for (int j = 0; j < 4; ++j) { const v4u w = pv_[64 * j];
#pragma unroll
                for (int e = 0; e < 4; ++e) { const float a = bflo(w[e]), b2 = bfhi(w[e]); sv += a * a + b2 * b2; } }
            const v4u* pq_ = (const v4u*)(QL + (size_t)row * 1024) + plane;
#pragma unroll
            for (int j = 0; j < 2; ++j) { const v4u w = pq_[64 * j];
#pragma unroll
                for (int e = 0; e < 4; ++e) { const float a = bflo(w[e]), b2 = bfhi(w[e]); sq += a * a + b2 * b2; } }
            { const v4u w = *((const v4u*)(KVL + (size_t)row * 512) + plane);
#pragma unroll
                for (int e = 0; e < 4; ++e) { const float a = bflo(w[e]), b2 = bfhi(w[e]); sk += a * a + b2 * b2; } }
            sv = wave_sum(sv); sq = wave_sum(sq); sk = wave_sum(sk);
            float spe = 0.f;
            { const unsigned wv = (plane < 32) ? *((const unsigned*)(KPE + (size_t)row * 256) + plane) : 0u; const float e0 = bflo(wv), e1 = bfhi(wv); spe = e0 * e0 + e1 * e1;
              const int el = 2 * (plane & 31), i = el & 31; const float a0 = e0 * g_kn[128 + el], a1 = e1 * g_kn[129 + el];
              const float b0 = __shfl_xor(a0, 16), b1 = __shfl_xor(a1, 16);
              const float c0 = ROPE_C[(size_t)row * 32 + i], c1 = ROPE_C[(size_t)row * 32 + i + 1], s0 = ROPE_S[(size_t)row * 32 + i], s1 = ROPE_S[(size_t)row * 32 + i + 1];
              const float o0 = (el < 32) ? a0 * c0 - b0 * s0 : a0 * c0 + b0 * s0, o1 = (el < 32) ? a1 * c1 - b1 * s1 : a1 * c1 + b1 * s1;
              if (plane < 32) *(pg8::f32x2*)(PER + (size_t)row * 64 + el) = (pg8::f32x2){o0, o1}; }
            spe = wave_sum(spe);
            if (plane == 0) { RV[row] = 1.0f / sqrtf(sv * (1.0f / GMW) + EPS); RQ[row] = 1.0f / sqrtf(sq * (1.0f / QLORA) + EPS); RKV[row] = 1.0f / sqrtf(sk * (1.0f / KVLORA) + EPS); RPE[row] = spe; }
        }
        if (BOTH(3)) GRID_BAR();
    }

    if (IN(4)) {
        const int ptid = FTID, plane = ptid & 63;
        { pg8::Gemm g{QL, WUQ_T, QLORA, QLORA, M, NH * QKH, QLORA}; pg8::StaticOrder S; S.init(M, NH * QKH, F.G, (int)blockIdx.x);
          pg8::EpiRowScale<0> E{QB, NH * QKH, RQ};
          pg8::gemm_phase<pg8::EpiRowScale<0>, pg8::StaticOrder>(F.lds, g, S, E, F.wave); }
        { pg8::Gemm g{KVL, WUKV_T, KVLORA, KVLORA, M, NH * 256, KVLORA}; pg8::StaticOrder S; S.init(M, NH * 256, F.G, (int)blockIdx.x);
          pg8::EpiKV E{KB, VB, RKV, RPE, PER, g_kn, (PG8_LAS float*)(F.lds + RING_BYTES + 1024)};
          pg8::gemm_phase<pg8::EpiKV, pg8::StaticOrder>(F.lds, g, S, E, F.wave); }
        for (int u = F.vcu; u < BATCH * 16 * 8; u += F.G) { const int g_ = u & 7, n_ = (u >> 3) & 15, b_ = u >> 7;
            gmlp_unit(b_, n_, g_, UV, RV, w_s, b_s, g_v, AO, (char*)lds, F.wave); }
        if (BOTH(4)) GRID_BAR();
    }


    if (IN(6)) {
        const int ptid = FTID, plane = ptid & 63;
        const BgSrc BT{ws}; constexpr int ND = BG_ND;
        const int per = (ND + F.G - 1) / F.G;
        BgState BS; BS.cur = -1; BS.next = F.wave * F.G + F.vcu; BS.end = ND; BS.stride = NWAVES * F.G; (void)per;
        LAS unsigned char* bgbuf = F.lds + 86016 + F.wave * 8192; LAS unsigned char* bgsbuf = F.lds + 151552 + F.wave * 256;
        for (int it = F.vcu; it < BATCH * NH * 4; it += F.G) { const int bh = it >> 2, p = it & 3;
            attn_unit(bh >> 5, bh & 31, p, QB, KB, VB, AO, (char*)lds, g_qn, ROPE_C, ROPE_S, BT, BS, bgbuf, bgsbuf, F.wave);
            attn_unit(bh >> 5, bh & 31, 7 - p, QB, KB, VB, AO, (char*)lds, g_qn, ROPE_C, ROPE_S, BT, BS, bgbuf, bgsbuf, F.wave); }
        while (BS.cur >= 0 || BS.next < BS.end) bg_step(BT, BS, bgbuf, bgsbuf, plane);
        if (BOTH(6)) GRID_BAR();
    }

    if (IN(7)) {
        const int ptid = FTID, plane = ptid & 63;
        for (int row = gw; row < M; row += NGW) {
            const v4u* ar = (const v4u*)(AO + (size_t)row * 6144) + plane;
            v4u w[12];
#pragma unroll
            for (int j = 0; j < 12; ++j) w[j] = ar[64 * j];
            float ha = 0.f, hb = 0.f; float f[12][8];
#pragma unroll
            for (int j = 0; j < 12; ++j) {
#pragma unroll
                for (int e = 0; e < 4; ++e) { f[j][2 * e] = bflo(w[j][e]); f[j][2 * e + 1] = bfhi(w[j][e]); }
                had_reg<8>(f[j]);
#pragma unroll
                for (int e = 0; e < 8; ++e) { float x_ = f[j][e]; x_ = had_x(x_, 1, plane); x_ = had_x(x_, 2, plane); x_ = had_x(x_, 4, plane); f[j][e] = x_;
                    if (j < 4) ha = fmaxf(ha, fabsf(x_)); else hb = fmaxf(hb, fabsf(x_)); } }
#pragma unroll
            for (int o_ = 1; o_ < 64; o_ <<= 1) { ha = fmaxf(ha, __shfl_xor(ha, o_)); hb = fmaxf(hb, __shfl_xor(hb, o_)); }
            const float inva = ha > 0.f ? 127.0f / ha : 0.f, invb = hb > 0.f ? 127.0f / hb : 0.f;
            if (plane == 0) { SA[row] = ha * (1.0f / (127.0f * 64.0f)); SB[row] = hb * (1.0f / (127.0f * 64.0f)); }
#pragma unroll
            for (int j = 0; j < 12; ++j) { const float inv = j < 4 ? inva : invb; unsigned qv[8];
#pragma unroll
                for (int e = 0; e < 8; ++e) qv[e] = __float_as_uint(__builtin_fmaf(f[j][e], inv, 12582912.0f));
                const unsigned a01 = __builtin_amdgcn_perm(qv[1], qv[0], 0x0c0c0400u), a23 = __builtin_amdgcn_perm(qv[3], qv[2], 0x0c0c0400u), a45 = __builtin_amdgcn_perm(qv[5], qv[4], 0x0c0c0400u), a67 = __builtin_amdgcn_perm(qv[7], qv[6], 0x0c0c0400u);
                *(v2u*)(A8 + (size_t)row * 6144 + 8 * (plane + 64 * j)) = (v2u){__builtin_amdgcn_perm(a23, a01, 0x05040100u), __builtin_amdgcn_perm(a67, a45, 0x05040100u)}; }
        }
        GRID_BAR();
        pg8::Gemm g{(const bf16*)A8, (const bf16*)WAB8, 3072, 3072, M, DM, 3072}; pg8::StaticOrder S; S.init(M, DM, F.G, (int)blockIdx.x);
        pg8::EpiMixI8 E{GATES, MIXED, 1024 / 64, SA, SB, CSAB};
        pg8::gemm_phase<pg8::EpiMixI8, pg8::StaticOrder, PG8_ALIGN, PG8_SP2, true>(F.lds, g, S, E, F.wave);
        if (BOTH(7)) GRID_BAR();
    }

    if (IN(8)) {
        const int ptid = FTID, plane = ptid & 63;
        for (int row = gw; row < M; row += NGW) {
            const v4u* mr = (const v4u*)(MIXED + (size_t)row * DM) + plane;
            v4u w[8];
#pragma unroll
            for (int j = 0; j < 8; ++j) w[j] = mr[64 * j];
            float hm = 0.f; float f[8][8];
#pragma unroll
            for (int j = 0; j < 8; ++j) {
#pragma unroll
                for (int e = 0; e < 4; ++e) { f[j][2 * e] = bflo(w[j][e]); f[j][2 * e + 1] = bfhi(w[j][e]); }
                had_reg<8>(f[j]);
#pragma unroll
                for (int e = 0; e < 8; ++e) { float x_ = f[j][e]; x_ = had_x(x_, 1, plane); x_ = had_x(x_, 2, plane); x_ = had_x(x_, 4, plane); f[j][e] = x_; hm = fmaxf(hm, fabsf(x_)); } }
#pragma unroll
            for (int o_ = 1; o_ < 64; o_ <<= 1) hm = fmaxf(hm, __shfl_xor(hm, o_));
            const float inv = hm > 0.f ? 127.0f / hm : 0.f;
            if (plane == 0) MSTEP[row] = hm * (1.0f / (127.0f * 64.0f));
#pragma unroll
            for (int j = 0; j < 8; ++j) { unsigned qv[8];
#pragma unroll
                for (int e = 0; e < 8; ++e) qv[e] = __float_as_uint(__builtin_fmaf(f[j][e], inv, 12582912.0f));
                const unsigned a01 = __builtin_amdgcn_perm(qv[1], qv[0], 0x0c0c0400u), a23 = __builtin_amdgcn_perm(qv[3], qv[2], 0x0c0c0400u), a45 = __builtin_amdgcn_perm(qv[5], qv[4], 0x0c0c0400u), a67 = __builtin_amdgcn_perm(qv[7], qv[6], 0x0c0c0400u);
                *(v2u*)(M8 + (size_t)row * DM + 8 * (plane + 64 * j)) = (v2u){__builtin_amdgcn_perm(a23, a01, 0x05040100u), __builtin_amdgcn_perm(a67, a45, 0x05040100u)}; }
        }
        GRID_BAR();
        pg8::Gemm g{(const bf16*)M8, (const bf16*)WOUT8, DM / 2, DM / 2, M, DM, DM / 2}; pg8::StaticOrder S; S.init(M, DM, F.G, (int)blockIdx.x);
        pg8::EpiResI8 E{x, out, MOD + 2 * DM, MSTEP, CSO};
        pg8::gemm_phase<pg8::EpiResI8, pg8::StaticOrder, PG8_ALIGN, PG8_SP2, true>(F.lds, g, S, E, F.wave);
        if (BOTH(8)) GRID_BAR();
    }

    if (IN(9)) {
        const int ptid = FTID, plane = ptid & 63;
        LAS float* modl = (LAS float*)F.lds;
        for (int wgi = blockIdx.x; wgi < M / 32; wgi += F.G) {
            const int bb = wgi >> 6; const float* mb = MOD + (size_t)bb * NMODC;
#pragma unroll
            for (int j = 0; j < 2; ++j) { const int col = 4 * (ptid + 512 * j); const f32x4 g4 = *(const f32x4*)(g_norm2 + col), sh = *(const f32x4*)(mb + 3 * DM + col), sc = *(const f32x4*)(mb + 4 * DM + col);
                *(LAS f32x4*)(modl + col) = g4 * (sc + 1.0f); *(LAS f32x4*)(modl + DM + col) = sh; }
            LDS_WAIT(); __syncthreads();
#pragma unroll 1
            for (int i = 0; i < 4; ++i) { const int row = wgi * 32 + F.wave * 4 + i; const int pl = pg8::lane_id();
                const f32x4* xr = (const f32x4*)(out + (size_t)row * DM) + pl;
                f32x4 v[16]; float ss = 0.f;
#pragma unroll
                for (int j = 0; j < 16; ++j) { v[j] = xr[64 * j]; ss += (v[j].x * v[j].x + v[j].y * v[j].y) + (v[j].z * v[j].z + v[j].w * v[j].w); }
                const float r = 1.0f / sqrtf(wave_sum(ss) * (1.0f / DM) + EPS);
                float hm = 0.f;
#pragma unroll
                for (int j = 0; j < 16; ++j) { const int col = 4 * (pl + 64 * j);
                    const f32x4 ga = *(const LAS f32x4*)(modl + col), sh = *(const LAS f32x4*)(modl + DM + col);
                    const f32x4 hv = v[j] * r * ga + sh; v[j] = hv;
                    if constexpr (FF8 < DFF) *(v2u*)(HB + (size_t)row * DM + col) = (v2u){pk2(hv.x, hv.y), pk2(hv.z, hv.w)}; }
#pragma unroll
                for (int j = 0; j < 16; ++j) { f32x4 t = had4(v[j]);
#pragma unroll
                    for (int e = 0; e < 4; ++e) { float x_ = t[e]; x_ = had_x(x_, 1, pl); x_ = had_x(x_, 2, pl); x_ = had_x(x_, 4, pl); x_ = had_x(x_, 8, pl); t[e] = x_; }
                    v[j] = t; hm = fmaxf(fmaxf(hm, fmaxf(fabsf(t.x), fabsf(t.y))), fmaxf(fabsf(t.z), fabsf(t.w))); }
#pragma unroll
                for (int o_ = 1; o_ < 64; o_ <<= 1) hm = fmaxf(hm, __shfl_xor(hm, o_));
                const float inv = hm > 0.f ? 127.0f / hm : 0.f;
                if (pl == 0) HSTEP[row] = hm * (1.0f / (127.0f * 64.0f));
#pragma unroll
                for (int j = 0; j < 16; ++j) { const int col = 4 * (pl + 64 * j);
                    const unsigned q0 = __float_as_uint(__builtin_fmaf(v[j].x, inv, 12582912.0f)), q1 = __float_as_uint(__builtin_fmaf(v[j].y, inv, 12582912.0f)), q2 = __float_as_uint(__builtin_fmaf(v[j].z, inv, 12582912.0f)), q3 = __float_as_uint(__builtin_fmaf(v[j].w, inv, 12582912.0f));
                    *(unsigned*)(H28 + (size_t)row * DM + col) = __builtin_amdgcn_perm(__builtin_amdgcn_perm(q3, q2, 0x0c0c0400u), __builtin_amdgcn_perm(q1, q0, 0x0c0c0400u), 0x05040100u); } }
            LDS_WAIT(); __syncthreads();
        }
        if (BOTH(9)) GRID_BAR();
    }

    if (IN(10)) {
        const int ptid = FTID, plane = ptid & 63;
        { pg8::Gemm g{(const bf16*)H28, (const bf16*)WFF18, DM / 2, DM / 2, M, FF8, DM / 2}; pg8::StaticOrder S; S.init(M, FF8, F.G, (int)blockIdx.x);
          pg8::EpiActI8<3> E{F1, DFF, HSTEP, CSF};
          pg8::gemm_phase<pg8::EpiActI8<3>, pg8::StaticOrder, PG8_ALIGN, PG8_SP2, true>(F.lds, g, S, E, F.wave); }
        if constexpr (FF8 < DFF) { pg8::Gemm g{HB, WFF1_T + (size_t)FF8 * DM, DM, DM, M, DFF - FF8, DM}; pg8::StaticOrder S; S.init(M, DFF - FF8, F.G, (int)blockIdx.x);
          pg8::EpiRowScale<3> E{F1 + FF8, DFF, nullptr};
          pg8::gemm_phase<pg8::EpiRowScale<3>, pg8::StaticOrder>(F.lds, g, S, E, F.wave); }
        if (BOTH(10)) GRID_BAR();
    }

    if (IN(11)) {
        const int ptid = FTID, plane = ptid & 63;
        pg8::Gemm g{F1, WFF2_T, DFF, DFF, M, DM, DFF}; pg8::StaticOrder S; S.init(M, DM, F.G, (int)blockIdx.x);
        pg8::EpiRes E{out, out, MOD + 5 * DM};
        pg8::gemm_phase<pg8::EpiRes, pg8::StaticOrder>(F.lds, g, S, E, F.wave);
    }
    if (DIAG_STOP >= 0 && IN(12)) {
        const int ptid = FTID, plane = ptid & 63;
        GRID_BAR();
        for (int row = gw; row < M; row += NGW) {
#pragma unroll 1
            for (int c = plane; c < DM; c += 64) {
                float v;
                if (DIAG_STOP == 6) { v = (c < 2048) ? bflo(AO[(size_t)row * 6144 + c]) : bflo(AO[(size_t)row * 6144 + c]) + bflo(AO[(size_t)row * 6144 + c + 2048]); }
                else if (DIAG_STOP == 2) { v = bflo(GATES[(size_t)row * 8192 + c]) + bflo(GATES[(size_t)row * 8192 + 4096 + c]); }
                else if (DIAG_STOP == 5) { v = bflo(QB[(size_t)row * 6144 + c]) + bflo(KB[(size_t)row * 6144 + c]) + bflo(VB[(size_t)row * 4096 + c]) + ((c < 2048) ? (bflo(QB[(size_t)row * 6144 + 4096 + c]) + bflo(KB[(size_t)row * 6144 + 4096 + c])) : 0.f); }
                else if (DIAG_STOP == 0) { v = bflo(WIN_T[(size_t)(NP_GATE + row) * DM + c]); }
                else if (DIAG_STOP == 7) { v = bflo(MIXED[(size_t)row * 4096 + c]); }
                else if (DIAG_STOP == 8) { v = 4.0f * (bflo(MIXED[(size_t)row * DM + c]) - (float)M8[(size_t)row * DM + c] * MSTEP[row]); }
                else if (DIAG_STOP == 10) { v = bflo(F1[(size_t)row * DFF + c]) + bflo(F1[(size_t)row * DFF + 4096 + c]) + bflo(F1[(size_t)row * DFF + 8192 + c]) + bflo(F1[(size_t)row * DFF + 12288 + c]); }
                else { v = 4.0f * (bflo(HB[(size_t)row * 4096 + c]) - (float)H8[(size_t)row * DM + c] * HSTEP[row]); }
                out[(size_t)row * DM + c] = v;
            }
        }
    }
#undef IN
#undef BOTH
#undef GRID_BAR
}

extern "C" void kernel_launch(void* const* d_in, const int* in_sizes, int n_in, void* d_out, int out_size, void* d_ws, size_t ws_size, hipStream_t stream) {
    static int grid = 0;
    if (grid == 0) {
        if (n_in != 22 || in_sizes[0] != M * DM || out_size != M * DM || ws_size < WS_END) { fprintf(stderr, "kernel_launch: shape / workspace mismatch (n_in %d, ws %zu, need %zu)\n", n_in, ws_size, (size_t)WS_END); grid = -1; return; }
        int dev = 0, cus = 0, per_cu = 0;
        if (hipGetDevice(&dev) != hipSuccess || hipDeviceGetAttribute(&cus, hipDeviceAttributeMultiprocessorCount, dev) != hipSuccess) { grid = -1; return; }
        if (hipFuncSetAttribute((const void*)hybrid_fwd, hipFuncAttributeMaxDynamicSharedMemorySize, LDS_BYTES) != hipSuccess) { fprintf(stderr, "kernel_launch: hipFuncSetAttribute failed\n"); grid = -1; return; }
        if (hipOccupancyMaxActiveBlocksPerMultiprocessor(&per_cu, (const void*)hybrid_fwd, NWAVES * 64, LDS_BYTES) != hipSuccess || per_cu < 1)
            fprintf(stderr, "kernel_launch: note: occupancy query reports %d workgroups per CU\n", per_cu);
        (void)hipGetLastError();
        grid = cus;
    }
    if (grid < 0) return;
    if (hipMemsetAsync((char*)d_ws + WS_CTL, 0, CTL_ZERO_BYTES, stream) != hipSuccess) { fprintf(stderr, "kernel_launch: memset failed\n"); return; }
    Args a{};
    for (int i = 0; i < 22; ++i) a.in[i] = (const float*)d_in[i];
    a.out = (float*)d_out; a.ws = (unsigned char*)d_ws;
    for (int i = 0; i < 32; ++i) { const float e = (float)(2 * i) / 64.0f; const float p = powf(10000.0f, e); a.inv_freq[i] = 1.0f / p; }
    constexpr int NPH = (DIAG_STOP >= 0) ? 13 : 12;
    for (int li = 0; li < ((MK_N_LAUNCHES == 1) ? 1 : NPH); ++li) {
        a.ph_lo = (MK_N_LAUNCHES == 1) ? 0 : li; a.ph_hi = (MK_N_LAUNCHES == 1) ? NPH : li + 1;
        if (DIAG_STOP >= 0 && MK_N_LAUNCHES != 1 && li > DIAG_STOP && li < 12) continue;
        hipLaunchKernelGGL(hybrid_fwd, dim3(grid), dim3(NWAVES * 64), LDS_BYTES, stream, a);
        const hipError_t le = hipPeekAtLastError();
        if (le != hipSuccess) { fprintf(stderr, "kernel_launch: launch %d failed: %s\n", li, hipGetErrorName(le)); break; }
    }
    if (PROBE_REDO >= 0) { a.ph_lo = PROBE_REDO; a.ph_hi = PROBE_REDO + 1; hipLaunchKernelGGL(hybrid_fwd, dim3(grid), dim3(NWAVES * 64), LDS_BYTES, stream, a); }
}
```

```cpp
#include <hip/hip_runtime.h>
#include <cstdio>
#include <cstdint>
#include <cmath>

#ifndef DIAG_STOP
#define DIAG_STOP -1
#endif
#ifndef PG8_SP2
#define PG8_SP2 true
#endif
#ifndef PG8_ALIGN
#define PG8_ALIGN true
#endif
#ifndef PG8_WGM
#define PG8_WGM 8
#endif
#ifndef PROBE_REDO
#define PROBE_REDO -1
#endif
#ifndef MK_N_LAUNCHES
#define MK_N_LAUNCHES 1
#endif

constexpr int UV8 = 4096;
namespace pg8 {
__device__ __forceinline__ int lane_id() { int l; asm volatile("v_mbcnt_lo_u32_b32 %0, -1, 0\n\tv_mbcnt_hi_u32_b32 %0, -1, %0" : "=v"(l)); return l; }
#define PG8_LAS __attribute__((address_space(3)))
typedef unsigned short bf16_t;
typedef short bf16x8 __attribute__((ext_vector_type(8)));
typedef float f32x4 __attribute__((ext_vector_type(4)));
typedef float f32x2 __attribute__((ext_vector_type(2)));
typedef unsigned u32x4 __attribute__((ext_vector_type(4)));
typedef unsigned u32x2 __attribute__((ext_vector_type(2)));
typedef int i32x4 __attribute__((ext_vector_type(4)));
constexpr int BM = 256, BK = 64, HALF = 128, HTB = HALF * BK * 2, STAGE_BYTES = 8 * HTB, NXCD = 8, WGM = PG8_WGM;

__host__ __device__ __forceinline__ int lds_byte(int r, int c) { const int st = (r >> 4) * 2 + (c >> 5), rr = r & 15, cc = c & 31, ob = rr * 64 + cc * 2; return st * 1024 + (ob ^ (((ob >> 9) & 1) << 5)); }
__host__ __device__ __forceinline__ void stage_rc(int b, int& R, int& C) { const int st = b / 1024, sb = b % 1024, swz = sb ^ (((sb >> 9) & 1) << 5); R = (st >> 1) * 16 + swz / 64; C = (st & 1) * 32 + (swz % 64) / 2; }
__host__ __device__ __forceinline__ int perm32(int rho) { const int n = rho >> 4, i = rho & 15; return 8 * (i >> 2) + 4 * n + (i & 3); }

struct Unit { int pm, pn; };
struct Gemm { const bf16_t* A; const bf16_t* Bt; int lda, ldb; int M, N, K; };

struct StaticOrder {
    int nM, nN, nwg, G, c;
    __host__ __device__ void init(int M, int N, int G_, int c_) { nM = M / BM; nN = N / BM; nwg = nM * nN; G = G_; c = c_; }
    __host__ __device__ bool next(int i, Unit& u) const {
        const long L = (long)i * G + c; if (L >= nwg) return false;
        int wgid = (int)L; { const int q = nwg / NXCD, r = nwg % NXCD, xcd = wgid % NXCD, off = wgid / NXCD; wgid = (xcd < r ? xcd * (q + 1) : r * (q + 1) + (xcd - r) * q) + off; }
        const int nig = WGM * nN, gid = wgid / nig, fm = gid * WGM, gsz = (nM - fm) < WGM ? (nM - fm) : WGM;
        u.pm = fm + ((wgid % nig) % gsz); u.pn = (wgid % nig) / gsz; return true;
    }
};

typedef __bf16 bf16x2_t __attribute__((ext_vector_type(2)));
__device__ __forceinline__ unsigned cvt_pk_bf16(float lo, float hi) { f32x2 v = {lo, hi}; bf16x2_t b = __builtin_convertvector(v, bf16x2_t); return __builtin_bit_cast(unsigned, b); }
__device__ __forceinline__ u32x4 pack8(f32x4 a, f32x4 b) { u32x4 w; w.x = cvt_pk_bf16(a[0], a[1]); w.y = cvt_pk_bf16(a[2], a[3]); w.z = cvt_pk_bf16(b[0], b[1]); w.w = cvt_pk_bf16(b[2], b[3]); return w; }
__device__ __forceinline__ float bf_lo(unsigned w) { return __uint_as_float(w << 16); }
__device__ __forceinline__ float bf_hi(unsigned w) { return __uint_as_float(w & 0xffff0000u); }
__device__ __forceinline__ f32x2 gelu_pk(f32x2 v) {
    const f32x2 av = __builtin_elementwise_abs(v), d = av * 0.2316418882f + 1.0f;
    f32x2 t; t.x = __builtin_amdgcn_rcpf(d.x); t.y = __builtin_amdgcn_rcpf(d.y);
    f32x2 q = t * 0.5307027145f + (-0.7265760135f); q = q * t + 0.7107068705f; q = q * t + (-0.142248368f); q = q * t + 0.127414796f; q = q * t;
    const f32x2 s = (v * v) * (-0.72134752044f);
    f32x2 e; e.x = __builtin_amdgcn_exp2f(s.x); e.y = __builtin_amdgcn_exp2f(s.y);
    const f32x2 m = v * (q * e), r = v - m;
    f32x2 o; o.x = v.x < 0.f ? m.x : r.x; o.y = v.y < 0.f ? m.y : r.y; return o;
}
template <int ACT> __device__ __forceinline__ f32x4 act4(f32x4 v) {
    if constexpr (ACT == 1) { const f32x2 a = gelu_pk((f32x2){v[0], v[1]}), b = gelu_pk((f32x2){v[2], v[3]}); return (f32x4){a.x, a.y, b.x, b.y}; }
    else if constexpr (ACT == 2) { f32x4 o;
#pragma unroll
        for (int i = 0; i < 4; ++i) o[i] = __builtin_amdgcn_rcpf(1.0f + __builtin_amdgcn_exp2f(-1.4426950408889634f * v[i])); return o; }
    else if constexpr (ACT == 3) { f32x4 o;
#pragma unroll
        for (int i = 0; i < 4; ++i) { const float r = v[i] > 0.f ? v[i] : 0.f; o[i] = r * r; } return o; }
    else return v;
}

template <int ACT> __device__ __forceinline__ void store_tile_bf16(const f32x4 (&acc)[2][2][4][2], bf16_t* dst, int ld, int row0, int col0) {
#pragma unroll
    for (int ai = 0; ai < 2; ++ai)
#pragma unroll
        for (int m = 0; m < 4; ++m) { bf16_t* rowp = dst + (size_t)(row0 + ai * HALF + m * 16) * ld + col0;
#pragma unroll
            for (int bj = 0; bj < 2; ++bj) *(u32x4*)(rowp + bj * HALF) = pack8(act4<ACT>(acc[ai][bj][m][0]), act4<ACT>(acc[ai][bj][m][1])); }
}
struct EpiProj {
    static constexpr bool PERM = true;
    bf16_t *UV, *QL, *KVL, *KPE, *GATES; int pn0;
    __device__ __forceinline__ void operator()(const f32x4 (&acc)[2][2][4][2], const Unit& u, int wr, int wc, int fr, int fq) const {
        const int row0 = u.pm * BM + wr * 64 + fr, cw = wc * 32 + 8 * fq, pn = u.pn + pn0;
        if (pn < 16) store_tile_bf16<1>(acc, UV, 4096, row0, pn * BM + cw);
        else if (pn < 20) store_tile_bf16<0>(acc, QL, 1024, row0, (pn - 16) * BM + cw);
        else if (pn < 22) store_tile_bf16<0>(acc, KVL, 512, row0, (pn - 20) * BM + cw);
        else if (pn == 22) store_tile_bf16<0>(acc, KPE, 256, row0, cw);
        else store_tile_bf16<2>(acc, GATES, 8192, row0, (pn - 23) * BM + cw);
    }
};
template <int ACT> struct EpiRowScale {
    static constexpr bool PERM = true;
    bf16_t* O; int ld; const float* rs;
    __device__ __forceinline__ void operator()(const f32x4 (&acc)[2][2][4][2], const Unit& u, int wr, int wc, int fr, int fq) const {
        const int row0 = u.pm * BM + wr * 64 + fr, col0 = u.pn * BM + wc * 32 + 8 * fq;
#pragma unroll
        for (int ai = 0; ai < 2; ++ai)
#pragma unroll
            for (int m = 0; m < 4; ++m) { const int row = row0 + ai * HALF + m * 16; const float s = rs ? rs[row] : 1.0f; bf16_t* rowp = O + (size_t)row * ld + col0;
#pragma unroll
                for (int bj = 0; bj < 2; ++bj) *(u32x4*)(rowp + bj * HALF) = pack8(act4<ACT>(acc[ai][bj][m][0] * s), act4<ACT>(acc[ai][bj][m][1] * s)); }
    }
};
struct EpiKV {
    static constexpr bool PERM = true;
    bf16_t *K, *V; const float *rkv, *rpe, *per, *g_kn; PG8_LAS float* P;
    __device__ __forceinline__ void operator()(const f32x4 (&acc)[2][2][4][2], const Unit& u, int wr, int wc, int fr, int fq) const {
        const int rl0 = wr * 64 + fr, row0 = u.pm * BM + rl0, h = u.pn, cw = wc * 32 + 8 * fq;
#pragma unroll
        for (int ai = 0; ai < 2; ++ai)
#pragma unroll
            for (int m = 0; m < 4; ++m) { const f32x4 a = acc[ai][0][m][0], b = acc[ai][0][m][1];
                float s = (a[0] * a[0] + a[1] * a[1]) + (a[2] * a[2] + a[3] * a[3]) + (b[0] * b[0] + b[1] * b[1]) + (b[2] * b[2] + b[3] * b[3]);
                s += __shfl_xor(s, 16); s += __shfl_xor(s, 32);
                if (fq == 0) P[(ai * HALF + rl0 + m * 16) * 4 + wc] = s; }
        asm volatile("s_waitcnt lgkmcnt(0)" ::: "memory"); __builtin_amdgcn_s_barrier(); asm volatile("" ::: "memory");
        const f32x4 g0 = *(const f32x4*)(g_kn + cw), g1 = *(const f32x4*)(g_kn + cw + 4);
#pragma unroll
        for (int ai = 0; ai < 2; ++ai)
#pragma unroll
            for (int m = 0; m < 4; ++m) { const int rl = ai * HALF + rl0 + m * 16, row = u.pm * BM + rl; const float s = rkv[row];
                const f32x4 ps = *(const PG8_LAS f32x4*)(P + rl * 4);
                const float rk = s / sqrtf((((ps[0] + ps[1]) + (ps[2] + ps[3])) * s * s + rpe[row]) * (1.0f / 192.0f) + 1e-6f);
                *(u32x4*)(K + (size_t)row * 6144 + h * 192 + cw) = pack8(acc[ai][0][m][0] * rk * g0, acc[ai][0][m][1] * rk * g1);
                *(u32x4*)(V + (size_t)row * 4096 + h * 128 + cw) = pack8(acc[ai][1][m][0] * s, acc[ai][1][m][1] * s); }
        { const int tid = (wr * 4 + wc) * 64 + fq * 16 + fr, rl = tid >> 1, part = tid & 1, row = u.pm * BM + rl; const float s = rkv[row];
          const f32x4 ps = *(const PG8_LAS f32x4*)(P + rl * 4);
          const float rk = 1.0f / sqrtf((((ps[0] + ps[1]) + (ps[2] + ps[3])) * s * s + rpe[row]) * (1.0f / 192.0f) + 1e-6f);
          const float* pp = per + (size_t)row * 64 + part * 32; bf16_t* kp = K + (size_t)row * 6144 + h * 192 + 128 + part * 32;
#pragma unroll
          for (int j = 0; j < 4; ++j) { const f32x4 a = *(const f32x4*)(pp + 8 * j), b = *(const f32x4*)(pp + 8 * j + 4); *(u32x4*)(kp + 8 * j) = pack8(a * rk, b * rk); } }
    }
};
struct EpiGateF32 {
    static constexpr bool PERM = true;
    float* T; const bf16_t* G;
    __device__ __forceinline__ void operator()(const f32x4 (&acc)[2][2][4][2], const Unit& u, int wr, int wc, int fr, int fq) const {
        const int row0 = u.pm * BM + wr * 64 + fr, col0 = u.pn * BM + wc * 32 + 8 * fq;
#pragma unroll
        for (int ai = 0; ai < 2; ++ai)
#pragma unroll
            for (int m = 0; m < 4; ++m) { const int row = row0 + ai * HALF + m * 16;
#pragma unroll
                for (int bj = 0; bj < 2; ++bj) { const u32x4 g = *(const u32x4*)(G + (size_t)row * 8192 + col0 + bj * HALF); float* tp = T + (size_t)row * 4096 + col0 + bj * HALF;
                    *(f32x4*)tp = acc[ai][bj][m][0] * (f32x4){bf_lo(g.x), bf_hi(g.x), bf_lo(g.y), bf_hi(g.y)};
                    *(f32x4*)(tp + 4) = acc[ai][bj][m][1] * (f32x4){bf_lo(g.z), bf_hi(g.z), bf_lo(g.w), bf_hi(g.w)}; } }
    }
};
struct EpiMix {
    static constexpr bool PERM = true;
    const float* T; const bf16_t* G; bf16_t* O;
    __device__ __forceinline__ void operator()(const f32x4 (&acc)[2][2][4][2], const Unit& u, int wr, int wc, int fr, int fq) const {
        const int row0 = u.pm * BM + wr * 64 + fr, col0 = u.pn * BM + wc * 32 + 8 * fq;
#pragma unroll
        for (int ai = 0; ai < 2; ++ai)
#pragma unroll
            for (int m = 0; m < 4; ++m) { const int row = row0 + ai * HALF + m * 16;
#pragma unroll
                for (int bj = 0; bj < 2; ++bj) { const u32x4 g = *(const u32x4*)(G + (size_t)row * 8192 + col0 + bj * HALF); const float* tp = T + (size_t)row * 4096 + col0 + bj * HALF;
                    const f32x4 t0 = *(const f32x4*)tp, t1 = *(const f32x4*)(tp + 4);
                    const f32x4 v0 = t0 + acc[ai][bj][m][0] * (f32x4){bf_lo(g.x), bf_hi(g.x), bf_lo(g.y), bf_hi(g.y)};
                    const f32x4 v1 = t1 + acc[ai][bj][m][1] * (f32x4){bf_lo(g.z), bf_hi(g.z), bf_lo(g.w), bf_hi(g.w)};
                    *(u32x4*)(O + (size_t)row * 4096 + col0 + bj * HALF) = pack8(v0, v1); } }
    }
};
struct EpiGateI8 {
    static constexpr bool PERM = true;
    bf16_t *UV, *G; const float *hs, *cs;
    template <int ACT> __device__ __forceinline__ void put(const f32x4 (&acc)[2][2][4][2], bf16_t* dst, int ld, int row0, int col0, int sc0) const {
        f32x4 cv[2][2];
#pragma unroll
        for (int bj = 0; bj < 2; ++bj)
#pragma unroll
            for (int n = 0; n < 2; ++n) cv[bj][n] = *(const f32x4*)(cs + sc0 + bj * HALF + n * 4);
#pragma unroll
        for (int ai = 0; ai < 2; ++ai)
#pragma unroll
            for (int m = 0; m < 4; ++m) { const int row = row0 + ai * HALF + m * 16; const float h = hs[row];
#pragma unroll
                for (int bj = 0; bj < 2; ++bj) {
                    const f32x4 v0 = __builtin_convertvector(__builtin_bit_cast(i32x4, acc[ai][bj][m][0]), f32x4) * (cv[bj][0] * h);
                    const f32x4 v1 = __builtin_convertvector(__builtin_bit_cast(i32x4, acc[ai][bj][m][1]), f32x4) * (cv[bj][1] * h);
                    *(u32x4*)(dst + (size_t)row * ld + col0 + bj * HALF) = pack8(act4<ACT>(v0), act4<ACT>(v1)); } }
    }
    __device__ __forceinline__ void operator()(const f32x4 (&acc)[2][2][4][2], const Unit& u, int wr, int wc, int fr, int fq) const {
        const int row0 = u.pm * BM + wr * 64 + fr, cw = wc * 32 + 8 * fq;
        if (u.pn < UV8 / 256) put<1>(acc, UV, 4096, row0, u.pn * BM + cw, u.pn * BM + cw);
        else put<2>(acc, G, 8192, row0, (u.pn - UV8 / 256) * BM + cw, u.pn * BM + cw);
    }
};
template <int ACT> struct EpiActI8 {
    static constexpr bool PERM = true;
    bf16_t* O; int ld; const float *hs, *cs;
    __device__ __forceinline__ void operator()(const f32x4 (&acc)[2][2][4][2], const Unit& u, int wr, int wc, int fr, int fq) const {
        const int row0 = u.pm * BM + wr * 64 + fr, col0 = u.pn * BM + wc * 32 + 8 * fq;
        f32x4 cv[2][2];
#pragma unroll
        for (int bj = 0; bj < 2; ++bj)
#pragma unroll
            for (int n = 0; n < 2; ++n) cv[bj][n] = *(const f32x4*)(cs + col0 + bj * HALF + n * 4);
#pragma unroll
        for (int ai = 0; ai < 2; ++ai)
#pragma unroll
            for (int m = 0; m < 4; ++m) { const int row = row0 + ai * HALF + m * 16; const float h = hs[row];
#pragma unroll
                for (int bj = 0; bj < 2; ++bj) {
                    const f32x4 v0 = __builtin_convertvector(__builtin_bit_cast(i32x4, acc[ai][bj][m][0]), f32x4) * (cv[bj][0] * h);
                    const f32x4 v1 = __builtin_convertvector(__builtin_bit_cast(i32x4, acc[ai][bj][m][1]), f32x4) * (cv[bj][1] * h);
                    *(u32x4*)(O + (size_t)row * ld + col0 + bj * HALF) = pack8(act4<ACT>(v0), act4<ACT>(v1)); } }
    }
};
struct EpiMixFused {
    static constexpr bool PERM = true, HAS_MID = true;
    const bf16_t* G; bf16_t* O; int tmid;
    __device__ __forceinline__ void mid(f32x4 (&acc)[2][2][4][2], const Unit& u, int wr, int wc, int fr, int fq) const {
        const char* gbase = (const char*)(G + (size_t)(u.pm * BM) * 8192 + u.pn * BM);
        unsigned loff = (unsigned)((wr * 64 + fr) * 8192 + wc * 32 + 8 * fq) * 2u;
        asm volatile("" : "+s"(gbase), "+v"(loff));
#pragma unroll
        for (int ai = 0; ai < 2; ++ai)
#pragma unroll
            for (int m = 0; m < 4; ++m) {
#pragma unroll
                for (int bj = 0; bj < 2; ++bj) { const char* gp = gbase + (size_t)((ai * HALF + m * 16) * 8192 + bj * HALF) * 2;
                    const u32x4 ga = *(const u32x4*)(gp + loff), gb = *(const u32x4*)(gp + 8192 + loff);
                    f32x4 r0, r1;
                    r0[0] = bf_lo(ga.x) * __builtin_amdgcn_rcpf(fmaxf(bf_lo(gb.x), 1e-30f)); r0[1] = bf_hi(ga.x) * __builtin_amdgcn_rcpf(fmaxf(bf_hi(gb.x), 1e-30f));
                    r0[2] = bf_lo(ga.y) * __builtin_amdgcn_rcpf(fmaxf(bf_lo(gb.y), 1e-30f)); r0[3] = bf_hi(ga.y) * __builtin_amdgcn_rcpf(fmaxf(bf_hi(gb.y), 1e-30f));
                    r1[0] = bf_lo(ga.z) * __builtin_amdgcn_rcpf(fmaxf(bf_lo(gb.z), 1e-30f)); r1[1] = bf_hi(ga.z) * __builtin_amdgcn_rcpf(fmaxf(bf_hi(gb.z), 1e-30f));
                    r1[2] = bf_lo(ga.w) * __builtin_amdgcn_rcpf(fmaxf(bf_lo(gb.w), 1e-30f)); r1[3] = bf_hi(ga.w) * __builtin_amdgcn_rcpf(fmaxf(bf_hi(gb.w), 1e-30f));
                    acc[ai][bj][m][0] *= r0; acc[ai][bj][m][1] *= r1; }
                asm volatile("" : "+v"(acc[ai][0][m][0]), "+v"(acc[ai][0][m][1]), "+v"(acc[ai][1][m][0]), "+v"(acc[ai][1][m][1]) :: "memory"); }
    }
    __device__ __forceinline__ void operator()(const f32x4 (&acc)[2][2][4][2], const Unit& u, int wr, int wc, int fr, int fq) const {
        const int row0 = u.pm * BM + wr * 64 + fr, col0 = u.pn * BM + wc * 32 + 8 * fq;
#pragma unroll
        for (int ai = 0; ai < 2; ++ai)
#pragma unroll
            for (int m = 0; m < 4; ++m) { const int row = row0 + ai * HALF + m * 16;
#pragma unroll
                for (int bj = 0; bj < 2; ++bj) { const u32x4 g = *(const u32x4*)(G + (size_t)row * 8192 + 4096 + col0 + bj * HALF);
                    const f32x4 v0 = acc[ai][bj][m][0] * (f32x4){bf_lo(g.x), bf_hi(g.x), bf_lo(g.y), bf_hi(g.y)};
                    const f32x4 v1 = acc[ai][bj][m][1] * (f32x4){bf_lo(g.z), bf_hi(g.z), bf_lo(g.w), bf_hi(g.w)};
                    *(u32x4*)(O + (size_t)row * 4096 + col0 + bj * HALF) = pack8(v0, v1); } }
    }
};
struct EpiMixI8 {
    static constexpr bool PERM = true, HAS_MID = true;
    const bf16_t* G; bf16_t* O; int tmid; const float *sa, *sb, *cs;
    template <bool FIN> __device__ __forceinline__ void run(f32x4 (&acc)[2][2][4][2], const Unit& u, int wr, int wc, int fr, int fq) const {
        const char* gbase = (const char*)(G + (size_t)(u.pm * BM) * 8192 + u.pn * BM + (FIN ? 4096 : 0));
        char* obase = (char*)(O + (size_t)(u.pm * BM) * 4096 + u.pn * BM);
        const char* cbase = (const char*)(cs + u.pn * BM); const char* rbase = (const char*)((FIN ? sb : sa) + u.pm * BM);
        unsigned goff = (unsigned)((wr * 64 + fr) * 8192 + wc * 32 + 8 * fq) * 2u, ooff = (unsigned)((wr * 64 + fr) * 4096 + wc * 32 + 8 * fq) * 2u, coff = (unsigned)(wc * 32 + 8 * fq) * 4u, roff = (unsigned)(wr * 64 + fr) * 4u;
        asm volatile("" : "+s"(gbase), "+s"(obase), "+s"(cbase), "+s"(rbase), "+v"(goff), "+v"(ooff), "+v"(coff), "+v"(roff));
        f32x4 cv[2][2];
#pragma unroll
        for (int bj = 0; bj < 2; ++bj) { cv[bj][0] = *(const f32x4*)(cbase + coff + bj * HALF * 4); cv[bj][1] = *(const f32x4*)(cbase + coff + bj * HALF * 4 + 16); }
#pragma unroll
        for (int ai = 0; ai < 2; ++ai)
#pragma unroll
            for (int m = 0; m < 4; ++m) { const int rl = ai * HALF + m * 16; const float rs = *(const float*)(rbase + roff + rl * 4);
#pragma unroll
                for (int bj = 0; bj < 2; ++bj) {
                    const u32x4 g = *(const u32x4*)(gbase + goff + (size_t)(rl * 8192 + bj * HALF) * 2);
                    char* op = obase + ooff + (size_t)(rl * 4096 + bj * HALF) * 2;
                    f32x4 v0 = __builtin_convertvector(__builtin_bit_cast(i32x4, acc[ai][bj][m][0]), f32x4) * (cv[bj][0] * rs) * (f32x4){bf_lo(g.x), bf_hi(g.x), bf_lo(g.y), bf_hi(g.y)};
                    f32x4 v1 = __builtin_convertvector(__builtin_bit_cast(i32x4, acc[ai][bj][m][1]), f32x4) * (cv[bj][1] * rs) * (f32x4){bf_lo(g.z), bf_hi(g.z), bf_lo(g.w), bf_hi(g.w)};
                    if constexpr (FIN) { const u32x4 pk = *(const u32x4*)op;
                        v0 += (f32x4){bf_lo(pk.x), bf_hi(pk.x), bf_lo(pk.y), bf_hi(pk.y)}; v1 += (f32x4){bf_lo(pk.z), bf_hi(pk.z), bf_lo(pk.w), bf_hi(pk.w)}; }
                    *(u32x4*)op = pack8(v0, v1);
                    if constexpr (!FIN) { acc[ai][bj][m][0] = (f32x4){0.f, 0.f, 0.f, 0.f}; acc[ai][bj][m][1] = (f32x4){0.f, 0.f, 0.f, 0.f}; } }
                if constexpr (!FIN) asm volatile("" : "+v"(acc[ai][0][m][0]), "+v"(acc[ai][0][m][1]), "+v"(acc[ai][1][m][0]), "+v"(acc[ai][1][m][1]) :: "memory"); }
    }
    __device__ __forceinline__ void mid(f32x4 (&acc)[2][2][4][2], const Unit& u, int wr, int wc, int fr, int fq) const { run<false>(acc, u, wr, wc, fr, fq); }
    __device__ __forceinline__ void operator()(const f32x4 (&acc)[2][2][4][2], const Unit& u, int wr, int wc, int fr, int fq) const { run<true>(const_cast<f32x4 (&)[2][2][4][2]>(acc), u, wr, wc, fr, fq); }
};
struct EpiRes {
    static constexpr bool PERM = false;
    const float* base; float* out; const float* mod;
    __device__ __forceinline__ void operator()(const f32x4 (&acc)[2][2][4][2], const Unit& u, int wr, int wc, int fr, int fq) const {
        const int row0 = u.pm * BM + wr * 64 + fr, col0 = u.pn * BM + wc * 32 + 4 * fq;
        const float* mb = mod + (size_t)(u.pm >> 3) * 24576 + col0;
        f32x4 gv[2][2];
#pragma unroll
        for (int bj = 0; bj < 2; ++bj)
#pragma unroll
            for (int n = 0; n < 2; ++n) gv[bj][n] = *(const f32x4*)(mb + bj * HALF + n * 16);
#pragma unroll
        for (int ai = 0; ai < 2; ++ai)
#pragma unroll
            for (int m = 0; m < 4; ++m) { const size_t off = (size_t)(row0 + ai * HALF + m * 16) * 4096 + col0;
#pragma unroll
                for (int bj = 0; bj < 2; ++bj)
#pragma unroll
                    for (int n = 0; n < 2; ++n) { const f32x4 b = *(const f32x4*)(base + off + bj * HALF + n * 16); *(f32x4*)(out + off + bj * HALF + n * 16) = b + gv[bj][n] * acc[ai][bj][m][n]; } }
    }
};

template <class T, class = void> struct has_mid { static constexpr bool value = false; };
template <class T> struct has_mid<T, decltype((void)T::HAS_MID)> { static constexpr bool value = T::HAS_MID; };
struct EpiResI8 {
    static constexpr bool PERM = true;
    const float* base; float* out; const float* mod; const float *ms, *cs;
    __device__ __forceinline__ void operator()(const f32x4 (&acc)[2][2][4][2], const Unit& u, int wr, int wc, int fr, int fq) const {
        const int row0 = u.pm * BM + wr * 64 + fr, col0 = u.pn * BM + wc * 32 + 8 * fq;
        const float* mb = mod + (size_t)(u.pm >> 3) * 24576 + col0;
        f32x4 gv[2][2];
#pragma unroll
        for (int bj = 0; bj < 2; ++bj)
#pragma unroll
            for (int n = 0; n < 2; ++n) gv[bj][n] = *(const f32x4*)(mb + bj * HALF + n * 4) * *(const f32x4*)(cs + col0 + bj * HALF + n * 4);
#pragma unroll
        for (int ai = 0; ai < 2; ++ai)
#pragma unroll
            for (int m = 0; m < 4; ++m) { const int row = row0 + ai * HALF + m * 16; const size_t off = (size_t)row * 4096 + col0; const float rs = ms[row];
#pragma unroll
                for (int bj = 0; bj < 2; ++bj)
#pragma unroll
                    for (int n = 0; n < 2; ++n) { const f32x4 b = *(const f32x4*)(base + off + bj * HALF + n * 4);
                        *(f32x4*)(out + off + bj * HALF + n * 4) = b + (gv[bj][n] * rs) * __builtin_convertvector(__builtin_bit_cast(i32x4, acc[ai][bj][m][n]), f32x4); } }
    }
};

template <class Epi, class Sched, bool ALIGN_EPI = PG8_ALIGN, bool SP2 = PG8_SP2, bool I8 = false>
__device__ __forceinline__ void gemm_phase(PG8_LAS unsigned char* lds, const Gemm g, const Sched& S, const Epi& E, const int wid) {
    const int lane = lane_id(), tid = wid * 64 + lane, wr = wid >> 2, wc = wid & 3, fr = lane & 15, fq = lane >> 4;
    const int K = g.K, nt = K / BK;
    unsigned voffA[2], voffB[2];
#pragma unroll
    for (int i = 0; i < 2; ++i) { int R, C; stage_rc(tid * 16 + i * 8192, R, C); const int Rb = Epi::PERM ? ((R & ~31) + perm32(R & 31)) : R;
        voffA[i] = (unsigned)(R * g.lda + C) * 2u; voffB[i] = (unsigned)(Rb * g.ldb + C) * 2u; }
    const size_t kstep = (size_t)(BK * 2);
    const size_t hstepA = (size_t)HALF * g.lda * 2, hstepB = (size_t)HALF * g.ldb * 2;
    const size_t tstepA = 2 * hstepA, tstepB = 2 * hstepB;
    const unsigned ldsw = (unsigned)wid * 1024u;
    const int aoff = lds_byte(wr * 64 + fr, fq * 8), boff = lds_byte(wc * 32 + fr, fq * 8);
#define PG8_SA(b, h) (((b) * 2 + (h)) * HTB)
#define PG8_SB(b, h) ((4 + (b) * 2 + (h)) * HTB)
#define PG8_STAGE(bufoff, gbase, voff) do { _Pragma("unroll") for (int _i = 0; _i < 2; ++_i) \
        __builtin_amdgcn_global_load_lds((const unsigned*)((const char*)(gbase) + (voff)[_i]), (PG8_LAS unsigned*)(lds + (bufoff) + ldsw + _i * 8192), 16, 0, 0); } while (0)
#define PG8_LDA(dst, b, h) do { _Pragma("unroll") for (int m = 0; m < 4; ++m) _Pragma("unroll") for (int k = 0; k < 2; ++k) dst[m][k] = *(const PG8_LAS bf16x8*)(lds + PG8_SA(b, h) + aoff + m * 2048 + k * 1024); } while (0)
#define PG8_LDB(dst, b, h) do { _Pragma("unroll") for (int n = 0; n < 2; ++n) _Pragma("unroll") for (int k = 0; k < 2; ++k) dst[n][k] = *(const PG8_LAS bf16x8*)(lds + PG8_SB(b, h) + boff + n * 2048 + k * 1024); } while (0)
#define PG8_MMA(ai, bj, At, Bt) do { __builtin_amdgcn_s_setprio(1); _Pragma("unroll") for (int m = 0; m < 4; ++m) _Pragma("unroll") for (int n = 0; n < 2; ++n) _Pragma("unroll") for (int k = 0; k < 2; ++k) \
        { if constexpr (I8) acc[ai][bj][m][n] = __builtin_bit_cast(f32x4, __builtin_amdgcn_mfma_i32_16x16x64_i8(__builtin_bit_cast(i32x4, Bt[n][k]), __builtin_bit_cast(i32x4, At[m][k]), __builtin_bit_cast(i32x4, acc[ai][bj][m][n]), 0, 0, 0)); \
          else acc[ai][bj][m][n] = __builtin_amdgcn_mfma_f32_16x16x32_bf16(Bt[n][k], At[m][k], acc[ai][bj][m][n], 0, 0, 0); } __builtin_amdgcn_s_setprio(0); } while (0)
#define PG8_WAIT_V(n) asm volatile("s_waitcnt vmcnt(" #n ")" ::: "memory")
#define PG8_WAIT_L(n) asm volatile("s_waitcnt lgkmcnt(" #n ")" ::: "memory")
#define PG8_BAR __builtin_amdgcn_s_barrier()
#define PG8_SCHED __builtin_amdgcn_sched_barrier(0)
    Unit cur, nxt; int ui = 0;
    if (!S.next(0, cur)) return;
    f32x4 acc[2][2][4][2];
#pragma unroll
    for (int a = 0; a < 2; ++a)
#pragma unroll
        for (int b = 0; b < 2; ++b)
#pragma unroll
            for (int m = 0; m < 4; ++m)
#pragma unroll
                for (int n = 0; n < 2; ++n) acc[a][b][m][n] = (f32x4){0.f, 0.f, 0.f, 0.f};
    bf16x8 At[4][2], B0[2][2], B1[2][2];
    const char* cA = (const char*)g.A + (size_t)cur.pm * tstepA; const char* cB = (const char*)g.Bt + (size_t)cur.pn * tstepB;
    if constexpr (SP2) {
    PG8_STAGE(PG8_SB(0, 0), cB, voffB); PG8_STAGE(PG8_SB(0, 1), cB + hstepB, voffB); PG8_STAGE(PG8_SA(0, 0), cA, voffA); PG8_STAGE(PG8_SA(0, 1), cA + hstepA, voffA);
    if (wr == 1) PG8_BAR;
    PG8_WAIT_V(2); PG8_BAR;
    PG8_STAGE(PG8_SB(1, 0), cB + kstep, voffB); PG8_STAGE(PG8_SA(1, 0), cA + kstep, voffA); PG8_STAGE(PG8_SB(1, 1), cB + hstepB + kstep, voffB);
    PG8_WAIT_V(6); PG8_BAR;
    } else {
    PG8_STAGE(PG8_SB(0, 0), cB, voffB); PG8_STAGE(PG8_SA(0, 0), cA, voffA); PG8_STAGE(PG8_SB(0, 1), cB + hstepB, voffB); PG8_STAGE(PG8_SA(0, 1), cA + hstepA, voffA);
    if (wr == 1) PG8_BAR;
    PG8_WAIT_V(4); PG8_BAR;
    PG8_STAGE(PG8_SB(1, 0), cB + kstep, voffB); PG8_STAGE(PG8_SA(1, 0), cA + kstep, voffA); PG8_STAGE(PG8_SB(1, 1), cB + hstepB + kstep, voffB);
    PG8_WAIT_V(6); PG8_BAR;
    }
    for (;;) {
        const bool has_next = S.next(ui + 1, nxt);
        const char* nA = has_next ? (const char*)g.A + (size_t)nxt.pm * tstepA : cA; const char* nB = has_next ? (const char*)g.Bt + (size_t)nxt.pn * tstepB : cB;
        asm volatile(".p2align 6");
        for (int t = 0; t < nt; t += 2) {
            if constexpr (has_mid<Epi>::value) { if (t == E.tmid) E.mid(acc, cur, wr, wc, fr, fq); }
            const bool last = (t == nt - 2);
            const char* a1 = cA + (size_t)(t + 1) * kstep;
            const char* a2 = last ? nA : cA + (size_t)(t + 2) * kstep; const char* b2 = last ? nB : cB + (size_t)(t + 2) * kstep;
            const char* a3 = a2 + kstep; const char* b3 = b2 + kstep;
            if constexpr (SP2) {
            PG8_LDB(B0, 0, 0); PG8_LDB(B1, 0, 1); PG8_SCHED; PG8_LDA(At, 0, 0); PG8_STAGE(PG8_SA(1, 1), a1 + hstepA, voffA);
            PG8_WAIT_V(8); PG8_WAIT_L(0); PG8_BAR; PG8_MMA(0, 0, At, B0); PG8_MMA(0, 1, At, B1); PG8_BAR; PG8_SCHED;
            PG8_LDA(At, 0, 1); PG8_STAGE(PG8_SB(0, 0), b2, voffB); PG8_STAGE(PG8_SB(0, 1), b2 + hstepB, voffB); PG8_STAGE(PG8_SA(0, 0), a2, voffA);
            PG8_WAIT_V(8); PG8_WAIT_L(0); PG8_BAR; PG8_MMA(1, 0, At, B0); PG8_MMA(1, 1, At, B1); PG8_BAR; PG8_SCHED;
            PG8_LDB(B0, 1, 0); PG8_LDB(B1, 1, 1); PG8_SCHED; PG8_LDA(At, 1, 0); PG8_STAGE(PG8_SA(0, 1), a2 + hstepA, voffA);
            PG8_WAIT_V(8); PG8_WAIT_L(0); PG8_BAR; PG8_MMA(0, 0, At, B0); PG8_MMA(0, 1, At, B1); PG8_BAR; PG8_SCHED;
            PG8_LDA(At, 1, 1); PG8_STAGE(PG8_SB(1, 0), b3, voffB); PG8_STAGE(PG8_SB(1, 1), b3 + hstepB, voffB); PG8_STAGE(PG8_SA(1, 0), a3, voffA);
            PG8_WAIT_V(8); PG8_WAIT_L(0); PG8_BAR; PG8_MMA(1, 0, At, B0); PG8_MMA(1, 1, At, B1); PG8_BAR; PG8_SCHED;
            } else {
            PG8_LDB(B0, 0, 0); PG8_SCHED; PG8_LDA(At, 0, 0); PG8_STAGE(PG8_SA(1, 1), a1 + hstepA, voffA);
            PG8_WAIT_L(8); PG8_BAR; PG8_WAIT_L(0); PG8_MMA(0, 0, At, B0); PG8_BAR; PG8_SCHED;
            PG8_LDB(B1, 0, 1); PG8_STAGE(PG8_SB(0, 0), b2, voffB);
            PG8_BAR; PG8_WAIT_L(0); PG8_MMA(0, 1, At, B1); PG8_BAR;
            PG8_LDA(At, 0, 1); PG8_STAGE(PG8_SA(0, 0), a2, voffA);
            PG8_BAR; PG8_WAIT_L(0); PG8_MMA(1, 0, At, B0); PG8_BAR; PG8_SCHED;
            PG8_STAGE(PG8_SB(0, 1), b2 + hstepB, voffB);
            PG8_WAIT_V(6); PG8_BAR; PG8_MMA(1, 1, At, B1); PG8_BAR;
            PG8_LDB(B0, 1, 0); PG8_SCHED; PG8_LDA(At, 1, 0); PG8_STAGE(PG8_SA(0, 1), a2 + hstepA, voffA);
            PG8_WAIT_L(8); PG8_BAR; PG8_WAIT_L(0); PG8_MMA(0, 0, At, B0); PG8_BAR; PG8_SCHED;
            PG8_LDB(B1, 1, 1); PG8_STAGE(PG8_SB(1, 0), b3, voffB);
            PG8_BAR; PG8_WAIT_L(0); PG8_MMA(0, 1, At, B1); PG8_BAR;
            PG8_LDA(At, 1, 1); PG8_STAGE(PG8_SA(1, 0), a3, voffA);
            PG8_BAR; PG8_WAIT_L(0); PG8_MMA(1, 0, At, B0); PG8_BAR; PG8_SCHED;
            PG8_STAGE(PG8_SB(1, 1), b3 + hstepB, voffB);
            PG8_WAIT_V(6); PG8_BAR; PG8_MMA(1, 1, At, B1); PG8_BAR;
            }
        }
        if constexpr (ALIGN_EPI) { if (wr == 0) PG8_BAR; }
        E(acc, cur, wr, wc, fr, fq);
        if (!has_next) break;
#pragma unroll
        for (int a = 0; a < 2; ++a)
#pragma unroll
            for (int b = 0; b < 2; ++b)
#pragma unroll
                for (int m = 0; m < 4; ++m)
#pragma unroll
                    for (int n = 0; n < 2; ++n) acc[a][b][m][n] = (f32x4){0.f, 0.f, 0.f, 0.f};
        cur = nxt; cA = nA; cB = nB; ++ui;
        if constexpr (ALIGN_EPI) { if (wr == 1) PG8_BAR; }
    }
    PG8_WAIT_V(0);
    if constexpr (!ALIGN_EPI) { if (wr == 0) PG8_BAR; }
    PG8_BAR;
#undef PG8_SA
#undef PG8_SB
#undef PG8_STAGE
#undef PG8_LDA
#undef PG8_LDB
#undef PG8_MMA
#undef PG8_WAIT_V
#undef PG8_WAIT_L
#undef PG8_BAR
#undef PG8_SCHED
}
}

constexpr int NWAVES = 8;
constexpr int BATCH = 4, SEQ = 2048, DM = 4096, M = BATCH * SEQ;
constexpr int GMW = 2048, NH = 32, QKH = 192, VH = 128, QLORA = 1024, KVLORA = 512, DFF = 16384, NMODC = 6 * DM;
constexpr int IN_COLS = 13888, OFF_GATE = 5696, NPAD = 14080, NP_GATE = 5888;
constexpr float EPS = 1e-6f;
constexpr float QSCALE = 0.07216878364870322f * 1.4426950408889634f;
constexpr int KSPLIT = 32, KCH = DM / KSPLIT;

constexpr size_t MiB = 1u << 20;
constexpr size_t WS_CTL = 0, CTL_ZERO_BYTES = 64 * 1024;
constexpr size_t WS_MOD = 1 * MiB, WS_STATS = 2 * MiB, WS_ROPE = 3 * MiB, WS_MODP = 5 * MiB;
constexpr size_t WS_WIN = 20 * MiB, WS_WUQ = 130 * MiB, WS_WUKV = 142 * MiB, WS_WAB = 150 * MiB, WS_WOUT = 198 * MiB, WS_WFF1 = 230 * MiB, WS_WFF2 = 358 * MiB;
constexpr size_t WS_H = 486 * MiB, WS_UV = 550 * MiB, WS_QL = 614 * MiB, WS_KVL = 630 * MiB, WS_KPE = 638 * MiB, WS_GATES = 642 * MiB, WS_AO = 770 * MiB;
constexpr size_t WS_Q = 866 * MiB, WS_KN = 962 * MiB, WS_V = 1026 * MiB, WS_K = 1090 * MiB, WS_MIXED = 1186 * MiB, WS_END = 1250 * MiB;
constexpr int NQ8 = UV8 + 8192;
constexpr size_t WS_WG8 = WS_WIN + 46 * MiB, WS_H8 = UV8 ? WS_WIN : WS_WIN + 78 * MiB;
constexpr size_t WS_CMAXP = WS_KN + 54 * MiB  , WS_CS = WS_KN + 2 * MiB, WS_HS = WS_KN + 3 * MiB;
constexpr int FF8 = 16384;
constexpr size_t WS_CMAXF = WS_KN + 40 * MiB, WS_CSF = WS_KN + 46 * MiB;
constexpr size_t WS_MS = WS_KN + 4 * MiB, WS_CSO = WS_KN + 5 * MiB, WS_CMAXO = WS_KN + 6 * MiB, WS_M8 = WS_KN + 8 * MiB;
constexpr size_t WS_CMAXAB = WS_KN + 48 * MiB, WS_CSAB = WS_KN + 50 * MiB, WS_SA = WS_KN + 51 * MiB, WS_SB = WS_KN + 52 * MiB, WS_A8 = WS_Q;
constexpr size_t WS_T = WS_Q;
constexpr size_t WS_F1 = WS_UV;
static_assert(WS_T + (size_t)M * 4096 * 4 <= WS_V && WS_F1 + (size_t)M * DFF * 2 <= WS_Q, "overlays");
constexpr int CW_BAR = 4096;

constexpr int RING_BYTES = 131072, LDS_BYTES = 163840, LDSCTL_OFF = LDS_BYTES - 512, MISC_OFF = LDSCTL_OFF + 320;

#define GAS __attribute__((address_space(1)))
#define LAS __attribute__((address_space(3)))
typedef unsigned short bf16;
typedef unsigned v4u __attribute__((ext_vector_type(4)));
typedef unsigned v2u __attribute__((ext_vector_type(2)));
typedef float f32x4 __attribute__((ext_vector_type(4)));
typedef float f32x16 __attribute__((ext_vector_type(16)));
typedef short bf16x8 __attribute__((ext_vector_type(8)));
typedef short s16x4 __attribute__((ext_vector_type(4)));
typedef GAS unsigned gu32;
#define RLX_AGENT __ATOMIC_RELAXED, __HIP_MEMORY_SCOPE_AGENT
#define LDS_WAIT() asm volatile("s_waitcnt lgkmcnt(0)" ::: "memory")
#define VM_WAIT() asm volatile("s_waitcnt vmcnt(0)" ::: "memory")
__device__ __forceinline__ unsigned f2bf(float f) { unsigned u = __builtin_bit_cast(unsigned, f); return (u + 0x7fffu + ((u >> 16) & 1u)) >> 16; }
__device__ __forceinline__ unsigned pk2(float lo, float hi) { return f2bf(lo) | (f2bf(hi) << 16); }
__device__ __forceinline__ float bflo(unsigned w) { return __uint_as_float(w << 16); }
__device__ __forceinline__ float bfhi(unsigned w) { return __uint_as_float(w & 0xffff0000u); }
__device__ __forceinline__ float wave_sum(float v) {
#pragma unroll
    for (int o = 1; o < 64; o <<= 1) v += __shfl_xor(v, o);
    return v;
}

#define XB_TMO      128
#define XB_XCNT(j)  (256  + 64 * (j))
#define XB_XSUB(j)  (1280 + 64 * (j))
#define XB_XGEN(j)  (2304 + 64 * (j))
#define XB_TOP      3328
#define XB_TOPGEN   3392
#define XCD_BAR_WORDS 3456
#define XB_SPIN_CAP (1u << 18)
__device__ __forceinline__ unsigned xb_ld(unsigned* p)              { return __hip_atomic_load(p, __ATOMIC_RELAXED, __HIP_MEMORY_SCOPE_AGENT); }
__device__ __forceinline__ unsigned xb_add(unsigned* p, unsigned v) { return __hip_atomic_fetch_add(p, v, __ATOMIC_RELAXED, __HIP_MEMORY_SCOPE_AGENT); }
__device__ __forceinline__ unsigned xb_xcc_id() { return (unsigned)__builtin_amdgcn_s_getreg((3 << 11) | 20) & 0xFu; }
#define XB_SPIN(cond, bar) do { unsigned _sp = 0; while (cond) { __builtin_amdgcn_s_sleep(1); \
    if ((++_sp & 255u) == 0u) { if (xb_ld(&(bar)[XB_TMO])) break; if (_sp > XB_SPIN_CAP) { atomicAdd(&(bar)[XB_TMO], 1u); break; } } } } while (0)
struct XcdBarrier { unsigned* bar; unsigned x; volatile LAS unsigned* st; int wave; };
__device__ __forceinline__ XcdBarrier xcd_barrier_post(unsigned* bar, volatile LAS unsigned* st, int wave) {
    XcdBarrier b; b.bar = bar; b.x = xb_xcc_id(); b.st = st; b.wave = wave;
    if (wave == 0 && pg8::lane_id() == 0) (void)xb_add(&bar[XB_XCNT(b.x)], 1u);
    return b;
}
__device__ __forceinline__ void xcd_barrier_complete(unsigned* bar, unsigned x, unsigned& nloc, unsigned& nx) {
    const unsigned G = gridDim.x * gridDim.y * gridDim.z;
    unsigned sum, cnt, mine, sp = 0u;
    for (;;) {
        sum = 0u; cnt = 0u; mine = 0u;
#pragma unroll
        for (unsigned j = 0; j < 16; ++j) { const unsigned c = xb_ld(&bar[XB_XCNT(j)]); sum += c; cnt += (c > 0u) ? 1u : 0u; mine = (j == x) ? c : mine; }
        if (sum == G) break;
        __builtin_amdgcn_s_sleep(1);
        if ((++sp & 255u) == 0u) { if (xb_ld(&bar[XB_TMO])) break; if (sp > XB_SPIN_CAP) { atomicAdd(&bar[XB_TMO], 1u); break; } }
    }
    nloc = mine > 0u ? mine : 1u; nx = cnt > 0u ? cnt : 1u;
}
__device__ __forceinline__ void xcd_barrier(const XcdBarrier& b) {
    asm volatile("s_waitcnt vmcnt(0)" ::: "memory");
    __syncthreads();
    if (b.wave == 0 && pg8::lane_id() == 0) {
        unsigned* bar = b.bar;
        __builtin_amdgcn_s_waitcnt(0);
        unsigned nloc = b.st[0], nx = b.st[1];
        if (nloc == 0u) { xcd_barrier_complete(bar, b.x, nloc, nx); b.st[0] = nloc; b.st[1] = nx; }
        const unsigned old = xb_add(&bar[XB_XSUB(b.x)], 1u);
        const unsigned gen = old / nloc;
        if (old + 1u == (gen + 1u) * nloc) {
            __builtin_amdgcn_fence(__ATOMIC_RELEASE, "agent");
            asm volatile("s_waitcnt vmcnt(0)" ::: "memory");
            const unsigned og = xb_add(&bar[XB_TOP], 1u);
            const unsigned tg = og / nx;
            if (og + 1u == (tg + 1u) * nx) xb_add(&bar[XB_TOPGEN], 1u);
            else XB_SPIN(xb_ld(&bar[XB_TOPGEN]) == tg, bar);
            __builtin_amdgcn_fence(__ATOMIC_ACQUIRE, "agent");
            xb_add(&bar[XB_XGEN(b.x)], 1u);
            asm volatile("s_waitcnt vmcnt(0)" ::: "memory");
        } else {
            XB_SPIN(xb_ld(&bar[XB_XGEN(b.x)]) == gen, bar);
            __builtin_amdgcn_fence(__ATOMIC_ACQUIRE, "agent");
            asm volatile("s_waitcnt vmcnt(0)" ::: "memory");
        }
    }
    __syncthreads();
}

struct Args { const float* in[22]; float* out; unsigned char* ws; float inv_freq[32]; int ph_lo, ph_hi; };
__device__ __forceinline__ f32x4 had4(const f32x4 v) { const float a = v.x + v.y, b = v.x - v.y, c = v.z + v.w, d = v.z - v.w; return (f32x4){a + c, b + d, a - c, b - d}; }
template <int CTRL> __device__ __forceinline__ float dpp_f(const float v) { return __int_as_float(__builtin_amdgcn_mov_dpp(__float_as_int(v), CTRL, 0xf, 0xf, true)); }
__device__ __forceinline__ float had_x(const float v, const int m, const int lane) {
    float p;
    if (m == 1) p = dpp_f<0xB1>(v);
    else if (m == 2) p = dpp_f<0x4E>(v);
    else if (m == 4) { const float up = dpp_f<0x104>(v), dn = dpp_f<0x114>(v); p = (lane & 4) ? dn : up; }
    else { const float up = dpp_f<0x108>(v), dn = dpp_f<0x118>(v); p = (lane & 8) ? dn : up; }
    return __builtin_fmaf(v, (lane & m) ? -1.0f : 1.0f, p);
}
template <int N_> __device__ __forceinline__ void had_reg(float (&w)[N_]) {
#pragma unroll
    for (int b = 1; b < N_; b <<= 1)
#pragma unroll
        for (int i = 0; i < N_; ++i) if (!(i & b)) { const float a = w[i], c = w[i + b]; w[i] = a + c; w[i + b] = a - c; }
}
__device__ __forceinline__ float rot_colmax64(const float* wp, const size_t ld) {
    float w[64];
#pragma unroll
    for (int kk = 0; kk < 64; ++kk) w[kk] = wp[(size_t)kk * ld];
    had_reg<64>(w);
    float mx = 0.f;
#pragma unroll
    for (int kk = 0; kk < 64; ++kk) mx = fmaxf(mx, fabsf(w[kk]));
    return mx;
}
struct Frame {
    LAS unsigned char* lds; int wave, vcu, G;
};

__device__ __forceinline__ void p0_transpose_item(const float* W, int N, bf16* WT, int ldt, int row_add, const float* gain, LAS float* scr, int kb, int nb, int lane) {
    const int k0 = 64 * kb, n0 = 32 * nb;
    { const float* wp = W + (size_t)(k0 + (lane >> 5)) * N + n0 + (lane & 31);
      float w[32];
#pragma unroll
      for (int i = 0; i < 32; ++i) w[i] = wp[(size_t)(2 * i) * N];
      if (gain) {
#pragma unroll
          for (int i = 0; i < 32; ++i) w[i] *= gain[k0 + 2 * i + (lane >> 5)]; }
#pragma unroll
      for (int i = 0; i < 32; ++i) scr[(2 * i + (lane >> 5)) * 33 + (lane & 31)] = w[i]; }
    LDS_WAIT(); asm volatile("" ::: "memory");
    const int c = lane & 7;
#pragma unroll
    for (int j = 0; j < 4; ++j) { const int n = (lane >> 3) + 8 * j; const LAS float* s = scr + (8 * c) * 33 + n;
        v4u o; o.x = pk2(s[0 * 33], s[1 * 33]); o.y = pk2(s[2 * 33], s[3 * 33]); o.z = pk2(s[4 * 33], s[5 * 33]); o.w = pk2(s[6 * 33], s[7 * 33]);
        *(v4u*)(WT + (size_t)(row_add + n0 + n) * ldt + k0 + 8 * c) = o; }
    LDS_WAIT(); asm volatile("" ::: "memory");
}
__device__ __forceinline__ void quant_transpose_item(const float* W, int N, signed char* WQ, int ldq, const float* step, LAS float* scr, int kb, int nb, int lane) {
    const int k0 = 64 * kb, n0 = 32 * nb;
    { const float* wp = W + (size_t)(k0 + (lane >> 5)) * N + n0 + (lane & 31);
      float w[32];
#pragma unroll
      for (int i = 0; i < 32; ++i) w[i] = wp[(size_t)(2 * i) * N];
#pragma unroll
      for (int i = 0; i < 32; ++i) scr[(2 * i + (lane >> 5)) * 33 + (lane & 31)] = w[i]; }
    LDS_WAIT(); asm volatile("" ::: "memory");
    const int c = lane & 7;
#pragma unroll
    for (int j = 0; j < 4; ++j) { const int n = (lane >> 3) + 8 * j; const LAS float* sp = scr + (8 * c) * 33 + n;
        const float st = step[n0 + n], inv = st > 0.f ? 1.0f / st : 0.f;
        int q[8]; float wv[8];
#pragma unroll
        for (int e = 0; e < 8; ++e) wv[e] = sp[e * 33];
        had_reg<8>(wv);
#pragma unroll
        for (int e = 0; e < 8; ++e) { wv[e] = had_x(wv[e], 1, lane); wv[e] = had_x(wv[e], 2, lane); wv[e] = had_x(wv[e], 4, lane); }
#pragma unroll
        for (int e = 0; e < 8; ++e) q[e] = (int)__float_as_uint(__builtin_fmaf(wv[e], inv, 12582912.0f));
        { const unsigned a01 = __builtin_amdgcn_perm((unsigned)q[1], (unsigned)q[0], 0x0c0c0400u), a23 = __builtin_amdgcn_perm((unsigned)q[3], (unsigned)q[2], 0x0c0c0400u), a45 = __builtin_amdgcn_perm((unsigned)q[5], (unsigned)q[4], 0x0c0c0400u), a67 = __builtin_amdgcn_perm((unsigned)q[7], (unsigned)q[6], 0x0c0c0400u);
          *(v2u*)(WQ + (size_t)(n0 + n) * ldq + k0 + 8 * c) = (v2u){__builtin_amdgcn_perm(a23, a01, 0x05040100u), __builtin_amdgcn_perm(a67, a45, 0x05040100u)}; } }
    LDS_WAIT(); asm volatile("" ::: "memory");
}
__device__ __forceinline__ void sincos_acc(float ang, float& c, float& s) {
    const double x = (double)ang, k = __builtin_rint(x * 0.15915494309189535), r = (x - k * 6.283185307179586) - k * 2.4492935982947064e-16, r2 = r * r;
    double sp = 1.0 / 2.585201673888498e22, cp = 1.0 / 6.204484017332394e23;
    const double sf[11] = {1.0 / 5.109094217170944e19, 1.0 / 1.21645100408832e17, 1.0 / 3.55687428096e14, 1.0 / 1.307674368e12, 1.0 / 6.2270208e9, 1.0 / 3.99168e7, 1.0 / 362880.0, 1.0 / 5040.0, 1.0 / 120.0, 1.0 / 6.0, 1.0};
    const double cf[12] = {1.0 / 1.1240007277776077e21, 1.0 / 2.43290200817664e18, 1.0 / 6.402373705728e15, 1.0 / 2.0922789888e13, 1.0 / 8.71782912e10, 1.0 / 4.790016e8, 1.0 / 3628800.0, 1.0 / 40320.0, 1.0 / 720.0, 1.0 / 24.0, 1.0 / 2.0, 1.0};
#pragma unroll
    for (int i = 0; i < 11; ++i) sp = sf[i] - sp * r2;
#pragma unroll
    for (int i = 0; i < 12; ++i) cp = cf[i] - cp * r2;
    s = (float)(sp * r); c = (float)cp;
}

#define SBAR() __builtin_amdgcn_sched_barrier(0)
constexpr int SHM_V = 64 * 128 * 2;
constexpr int KPITCH = 400, SHM_K = 64 * KPITCH;
__device__ __forceinline__ int v_st(int k, int c) { const int kk = (k & ~0xC) | ((k & 4) << 1) | ((k & 8) >> 1); return ((kk >> 3) * 4 + (c >> 5)) * 512 + ((kk & 7) * 32 + (c & 31)) * 2; }
__device__ __forceinline__ int v_rd_base(int lane) { return ((lane & 3) << 3) | (((lane >> 2) & 3) << 6) | (((lane >> 4) & 1) << 5) | (((lane >> 5) & 1) << 8); }
constexpr int v_rd_off(int d0, int ks, int half) { return d0 * 512 + ks * 4096 + half * 2048; }
__device__ __forceinline__ int crow(int r, int hi) { return (r & 3) + 8 * (r >> 2) + 4 * hi; }
__device__ __forceinline__ unsigned cvtpk(float lo, float hi) { return pg8::cvt_pk_bf16(lo, hi); }
template <int VOFF>
__device__ __forceinline__ void pv_tile(f32x16* o, int vb0, bf16x8 pa0, bf16x8 pa1, bf16x8 pa2, bf16x8 pa3) {
#define TRRD(dst, off) asm volatile("ds_read_b64_tr_b16 %0, %1 offset:%2" : "=&v"(dst) : "v"(vb0), "i"(off) : "memory")
#define PV_D0(d0) do { s16x4 l0, l1, l2, l3, h0, h1, h2, h3; constexpr int b_ = VOFF + v_rd_off(d0, 0, 0); \
        TRRD(l0, b_); TRRD(h0, b_ + 2048); TRRD(l1, b_ + 4096); TRRD(h1, b_ + 6144); TRRD(l2, b_ + 8192); TRRD(h2, b_ + 10240); TRRD(l3, b_ + 12288); TRRD(h3, b_ + 14336); \
        asm volatile("s_waitcnt lgkmcnt(0)" ::: "memory"); SBAR(); \
        o[d0] = __builtin_amdgcn_mfma_f32_32x32x16_bf16(pa0, (bf16x8){l0[0], l0[1], l0[2], l0[3], h0[0], h0[1], h0[2], h0[3]}, o[d0], 0, 0, 0); \
        o[d0] = __builtin_amdgcn_mfma_f32_32x32x16_bf16(pa1, (bf16x8){l1[0], l1[1], l1[2], l1[3], h1[0], h1[1], h1[2], h1[3]}, o[d0], 0, 0, 0); \
        o[d0] = __builtin_amdgcn_mfma_f32_32x32x16_bf16(pa2, (bf16x8){l2[0], l2[1], l2[2], l2[3], h2[0], h2[1], h2[2], h2[3]}, o[d0], 0, 0, 0); \
        o[d0] = __builtin_amdgcn_mfma_f32_32x32x16_bf16(pa3, (bf16x8){l3[0], l3[1], l3[2], l3[3], h3[0], h3[1], h3[2], h3[3]}, o[d0], 0, 0, 0); } while (0)
    PV_D0(0); PV_D0(1); PV_D0(2); PV_D0(3);
#undef PV_D0
#undef TRRD
}

struct BgState { int cur, next, end, stride; };
struct BgSrc { unsigned char* ws; };
constexpr int BG_C0 = 32 * 128, BG_C1 = 64 * 128, BG_C2 = 64 * 128, BG_C3 = 64 * 512, BG_C4 = 256 * 128, BG_ND = BG_C0 + BG_C1 + BG_C2 + BG_C3 + BG_C4;
constexpr size_t WS_BGTAB = 512 * 1024;
__device__ __forceinline__ void bg_find(const BgSrc S_, int d, const float*& W, bf16*& WT, int& N, int& ldt, int& kb, int& nb, int& mi) {
    unsigned char* ws = S_.ws;
    int r = d, i = 0;
    if (r >= BG_C0) { r -= BG_C0; i = 1; if (r >= BG_C1) { r -= BG_C1; i = 2; if (r >= BG_C2) { r -= BG_C2; i = 3; if (r >= BG_C3) { r -= BG_C3; i = 4; } } } }
    { typedef const float* __attribute__((address_space(4))) * kptr_t;
      const int k = (i < 3) ? 16 + i : 17 + i;
      W = ((kptr_t)__builtin_amdgcn_kernarg_segment_ptr())[k]; }
    const size_t woff = (i == 0) ? WS_WAB : (i == 1) ? WS_WAB + 2048   : (i == 2) ? WS_WOUT : (i == 3) ? WS_WFF1 : WS_WFF2;
    WT = (bf16*)(ws + woff);
    N = (i == 3) ? DFF : DM; ldt = (i < 2) ? 6144 : (i == 4) ? DFF : DM; const int nblk = (i == 3) ? 512 : 128;
    kb = r / nblk; nb = r - kb * nblk; mi = i;
}
__device__ __forceinline__ void bg_issue(const BgSrc ws, int d, LAS unsigned char* buf, LAS unsigned char* sbuf, int lane) {
    const float* W; bf16* WT; int N, ldt, kb, nb, mi; bg_find(ws, d, W, WT, N, ldt, kb, nb, mi);
    const int kr = lane >> 3, c = lane & 7;
    const float* src = W + (size_t)(64 * kb + kr) * N + 32 * nb;
#pragma unroll
    for (int j = 0; j < 8; ++j)
        __builtin_amdgcn_global_load_lds((const unsigned*)(src + (size_t)(8 * j) * N + 4 * ((c ^ kr ^ j) & 7)), (LAS unsigned*)(buf + j * 1024), 16, 0, 0);
    if (mi <= 2 || (mi == 3 && nb < FF8 / 32)) {
        const float* st = (const float*)(ws.ws + (mi < 2 ? WS_CSAB : mi == 2 ? WS_CSO : WS_CSF)) + 32 * nb + lane;
        __builtin_amdgcn_global_load_lds((const unsigned*)st, (LAS unsigned*)sbuf, 4, 0, 0); }
}
__device__ __forceinline__ void bg_process(const BgSrc ws, int d, LAS unsigned char* buf, LAS unsigned char* sbuf, int lane) {
    const float* W; bf16* WT; int N, ldt, kb, nb, mi; bg_find(ws, d, W, WT, N, ldt, kb, nb, mi);
    const int q = lane & 7;
    if (mi <= 2 || (mi == 3 && nb < FF8 / 32)) {
        signed char* WQ = (signed char*)WT;
#pragma unroll
        for (int jj = 0; jj < 4; ++jj) { const int n = (lane >> 3) + 8 * jj; float v[8];
#pragma unroll
            for (int r = 0; r < 8; ++r) v[r] = *(const LAS float*)(buf + (((8 * q + r) * 8 + (((n >> 2) ^ r ^ q) & 7)) * 16 + (n & 3) * 4));
            { had_reg<8>(v);
#pragma unroll
                for (int r = 0; r < 8; ++r) { v[r] = had_x(v[r], 1, lane); v[r] = had_x(v[r], 2, lane); v[r] = had_x(v[r], 4, lane); } }
            const float st = *(const LAS float*)(sbuf + n * 4), inv = st > 0.f ? 1.0f / st : 0.f;
            unsigned qv[8];
#pragma unroll
            for (int r = 0; r < 8; ++r) qv[r] = __float_as_uint(__builtin_fmaf(v[r], inv, 12582912.0f));
            const unsigned a01 = __builtin_amdgcn_perm(qv[1], qv[0], 0x0c0c0400u), a23 = __builtin_amdgcn_perm(qv[3], qv[2], 0x0c0c0400u), a45 = __builtin_amdgcn_perm(qv[5], qv[4], 0x0c0c0400u), a67 = __builtin_amdgcn_perm(qv[7], qv[6], 0x0c0c0400u);
            *(v2u*)(WQ + (size_t)(32 * nb + n) * (mi < 2 ? 6144 : DM) + 64 * kb + 8 * q) = (v2u){__builtin_amdgcn_perm(a23, a01, 0x05040100u), __builtin_amdgcn_perm(a67, a45, 0x05040100u)}; }
        return; }
#pragma unroll
    for (int jj = 0; jj < 4; ++jj) { const int n = (lane >> 3) + 8 * jj; float v[8];
#pragma unroll
        for (int r = 0; r < 8; ++r) v[r] = *(const LAS float*)(buf + (((8 * q + r) * 8 + (((n >> 2) ^ r ^ q) & 7)) * 16 + (n & 3) * 4));
        *(v4u*)(WT + (size_t)(32 * nb + n) * ldt + 64 * kb + 8 * q) = (v4u){pg8::cvt_pk_bf16(v[0], v[1]), pg8::cvt_pk_bf16(v[2], v[3]), pg8::cvt_pk_bf16(v[4], v[5]), pg8::cvt_pk_bf16(v[6], v[7])}; }
}
__device__ __forceinline__ void bg_step(const BgSrc T, BgState& B, LAS unsigned char* buf, LAS unsigned char* sbuf, int lane) {
    asm volatile("" : "+v"(lane));
    if (B.cur >= 0) { VM_WAIT(); bg_process(T, B.cur, buf, sbuf, lane); B.cur = -1; }
    if (B.next < B.end) { LDS_WAIT(); bg_issue(T, B.next, buf, sbuf, lane); B.cur = B.next; B.next += B.stride; }
}

constexpr float ATT_THR = 11.5f;
constexpr int ATT_LDS_V = 0, ATT_LDS_K = 2 * SHM_V, ATT_LDS_WS = 2 * SHM_V + 2 * SHM_K;
__device__ __forceinline__ void attn_unit(int b, int h, int qb, const bf16* Q, const bf16* Kg, const bf16* Vg, bf16* AO, char* lds, const float* g_qn, const float* ROPE_C, const float* ROPE_S, const BgSrc BT, BgState& BS, LAS unsigned char* bgbuf, LAS unsigned char* bgsbuf, const int wid) {
    const int lane = pg8::lane_id(), tid = wid * 64 + lane, r32 = lane & 31, hi = lane >> 5;
    const int rowbase = b * SEQ, q0 = qb * 256, NT = (q0 + 256) / 64;
    char* V_lds = lds + ATT_LDS_V; char* K_lds = lds + ATT_LDS_K;
    float* ws = (float*)(lds + ATT_LDS_WS) + wid * 64; float* li_l = ws; float* al_l = ws + 32;
    const int kkey = tid >> 3, kpart = tid & 7;
    const char* Kbase = (const char*)(Kg + ((size_t)rowbase * NH + h) * QKH);
    unsigned koffb = (unsigned)(kkey * NH * QKH + kpart * 8) * 2u;
    const int kws = kkey * KPITCH + kpart * 16;
    const int sr = tid >> 4, sc = (tid & 15) * 8, vst0 = v_st(sr, sc), vst1 = v_st(32 + sr, sc);
    const char* Vbase = (const char*)(Vg + ((size_t)rowbase * NH + h) * VH);
    unsigned voffb = (unsigned)(sr * NH * VH + sc) * 2u;
    asm volatile("" : "+v"(koffb), "+v"(voffb));
    const int vb0 = (int)(uintptr_t)V_lds + v_rd_base(lane);
    const int qlo = q0 + wid * 32, qm = qlo + r32 - 4 * hi;
    bf16x8 qr[12];
    { const char* qbase = (const char*)(Q + ((size_t)(rowbase + qlo) * NH + h) * QKH); unsigned qoffb = (unsigned)(r32 * NH * QKH + hi * 8) * 2u; asm volatile("" : "+v"(qoffb));
#pragma unroll
      for (int d0 = 0; d0 < 12; ++d0) qr[d0] = *(const bf16x8*)(qbase + qoffb + d0 * 32); }
    { float ss = 0.f;
#pragma unroll
      for (int d0 = 0; d0 < 12; ++d0) { const v4u w = __builtin_bit_cast(v4u, qr[d0]);
#pragma unroll
          for (int e = 0; e < 4; ++e) { const float a = bflo(w[e]), b2 = bfhi(w[e]); ss += a * a + b2 * b2; } }
      { auto rr = __builtin_amdgcn_permlane32_swap(__float_as_uint(ss), __float_as_uint(ss), false, false); ss = __uint_as_float(rr[0]) + __uint_as_float(rr[1]); }
      const float rs = QSCALE / sqrtf(ss * (1.0f / 192.0f) + EPS);
      unsigned goff = (unsigned)hi * 32u, roff = (unsigned)(r32 * 32 + hi * 8) * 4u;
      asm volatile("" : "+v"(goff), "+v"(roff));
      const float* gq = (const float*)((const char*)g_qn + goff);
#pragma unroll
      for (int d0 = 0; d0 < 8; ++d0) { const v4u w = __builtin_bit_cast(v4u, qr[d0]); const f32x4 g0 = *(const f32x4*)(gq + d0 * 16), g1 = *(const f32x4*)(gq + d0 * 16 + 4);
          const v4u o = {pk2(bflo(w[0]) * rs * g0[0], bfhi(w[0]) * rs * g0[1]), pk2(bflo(w[1]) * rs * g0[2], bfhi(w[1]) * rs * g0[3]),
                         pk2(bflo(w[2]) * rs * g1[0], bfhi(w[2]) * rs * g1[1]), pk2(bflo(w[3]) * rs * g1[2], bfhi(w[3]) * rs * g1[3])};
          qr[d0] = __builtin_bit_cast(bf16x8, o); }
      const float* cs = (const float*)((const char*)(ROPE_C + (size_t)(rowbase + qlo) * 32) + roff); const float* sn = (const float*)((const char*)(ROPE_S + (size_t)(rowbase + qlo) * 32) + roff);
#pragma unroll
      for (int d0 = 8; d0 < 10; ++d0) { const v4u wa = __builtin_bit_cast(v4u, qr[d0]), wb = __builtin_bit_cast(v4u, qr[d0 + 2]);
          const f32x4 g0 = *(const f32x4*)(gq + d0 * 16), g1 = *(const f32x4*)(gq + d0 * 16 + 4), h0 = *(const f32x4*)(gq + d0 * 16 + 32), h1 = *(const f32x4*)(gq + d0 * 16 + 36);
          const f32x4 c0 = *(const f32x4*)(cs + (d0 - 8) * 16), c1 = *(const f32x4*)(cs + (d0 - 8) * 16 + 4), s0 = *(const f32x4*)(sn + (d0 - 8) * 16), s1 = *(const f32x4*)(sn + (d0 - 8) * 16 + 4);
          float a[8], bq[8];
#pragma unroll
          for (int e = 0; e < 4; ++e) { a[2 * e] = bflo(wa[e]) * rs; a[2 * e + 1] = bfhi(wa[e]) * rs; bq[2 * e] = bflo(wb[e]) * rs; bq[2 * e + 1] = bfhi(wb[e]) * rs; }
#pragma unroll
          for (int e = 0; e < 4; ++e) { a[e] *= g0[e]; a[4 + e] *= g1[e]; bq[e] *= h0[e]; bq[4 + e] *= h1[e]; }
#pragma unroll
          for (int e = 0; e < 8; ++e) { const float c_ = e < 4 ? c0[e] : c1[e - 4], s_ = e < 4 ? s0[e] : s1[e - 4]; const float x1 = a[e], x2 = bq[e]; a[e] = x1 * c_ - x2 * s_; bq[e] = x2 * c_ + x1 * s_; }
          const v4u oa = {pk2(a[0], a[1]), pk2(a[2], a[3]), pk2(a[4], a[5]), pk2(a[6], a[7])}, ob = {pk2(bq[0], bq[1]), pk2(bq[2], bq[3]), pk2(bq[4], bq[5]), pk2(bq[6], bq[7])};
          qr[d0] = __builtin_bit_cast(bf16x8, oa); qr[d0 + 2] = __builtin_bit_cast(bf16x8, ob); } }
    bf16x8 sk0, sk1, sk2, sv0, sv1;
#define A_SLOAD(t) do { const char* kp_ = Kbase + (size_t)(t) * (64 * NH * QKH * 2); sk0 = *(const bf16x8*)(kp_ + koffb); sk1 = *(const bf16x8*)(kp_ + koffb + 128); sk2 = *(const bf16x8*)(kp_ + koffb + 256); \
        const char* vp_ = Vbase + (size_t)(t) * (64 * NH * VH * 2); sv0 = *(const bf16x8*)(vp_ + voffb); sv1 = *(const bf16x8*)(vp_ + voffb + 32 * NH * VH * 2); } while (0)
#define A_SWRITE(bf) do { char* kd_ = K_lds + (bf) * SHM_K + kws; *(bf16x8*)kd_ = sk0; *(bf16x8*)(kd_ + 128) = sk1; *(bf16x8*)(kd_ + 256) = sk2; \
        *(bf16x8*)(V_lds + (bf) * SHM_V + vst0) = sv0; *(bf16x8*)(V_lds + (bf) * SHM_V + vst1) = sv1; } while (0)
    float m_reg = -1e30f, l_reg = 0.f; f32x16 o[4] = {};
    A_SLOAD(0); VM_WAIT(); A_SWRITE(0); LDS_WAIT(); __syncthreads();
    const char* kb0 = K_lds + r32 * KPITCH + hi * 16;
#define A_STEP(t, BF) do { \
        if ((t) + 1 < NT) A_SLOAD((t) + 1); \
        if ((t) * 64 <= qlo + 31) {   \
        f32x16 p0 = {}, p1 = {}; \
        _Pragma("unroll") for (int d0 = 0; d0 < 12; ++d0) { const char* a_ = kb0 + (BF) * SHM_K + d0 * 32; \
            const bf16x8 k0_ = *(const bf16x8*)a_; const bf16x8 k1_ = *(const bf16x8*)(a_ + 32 * KPITCH); \
            p0 = __builtin_amdgcn_mfma_f32_32x32x16_bf16(k0_, qr[d0], p0, 0, 0, 0); p1 = __builtin_amdgcn_mfma_f32_32x32x16_bf16(k1_, qr[d0], p1, 0, 0, 0); if (d0 % 2 == 1) SBAR(); } \
        { const int kbase_ = (t) * 64; if (kbase_ + 63 > qlo) { const int dq_ = qm - kbase_; const float NEG_ = -__builtin_inff(); \
            _Pragma("unroll") for (int r = 0; r < 16; ++r) { const int c_ = (r & 3) + 8 * (r >> 2); if (dq_ - c_ < 0) p0[r] = NEG_; if (dq_ - c_ - 32 < 0) p1[r] = NEG_; } } } \
        float pmax_ = p0[0]; _Pragma("unroll") for (int r = 1; r < 16; ++r) pmax_ = fmaxf(pmax_, p0[r]); _Pragma("unroll") for (int r = 0; r < 16; ++r) pmax_ = fmaxf(pmax_, p1[r]); \
        { auto rr_ = __builtin_amdgcn_permlane32_swap(__float_as_uint(pmax_), __float_as_uint(pmax_), false, false); pmax_ = fmaxf(__uint_as_float(rr_[0]), __uint_as_float(rr_[1])); } \
        float mn_, alpha_; \
        if (__all(pmax_ - m_reg <= ATT_THR)) { mn_ = m_reg; alpha_ = 1.f; } else { mn_ = fmaxf(m_reg, pmax_); alpha_ = __builtin_amdgcn_exp2f(m_reg - mn_); m_reg = mn_; } \
        _Pragma("unroll") for (int r = 0; r < 16; ++r) { p0[r] = __builtin_amdgcn_exp2f(p0[r] - mn_); p1[r] = __builtin_amdgcn_exp2f(p1[r] - mn_); } \
        float ps_ = 0.f; _Pragma("unroll") for (int r = 0; r < 16; ++r) ps_ += p0[r]; _Pragma("unroll") for (int r = 0; r < 16; ++r) ps_ += p1[r]; \
        { auto rr_ = __builtin_amdgcn_permlane32_swap(__float_as_uint(ps_), __float_as_uint(ps_), false, false); ps_ = __uint_as_float(rr_[0]) + __uint_as_float(rr_[1]); } \
        l_reg = l_reg * alpha_ + ps_; \
        bf16x8 pa0_, pa1_, pa2_, pa3_; \
        A_PK4(p0, 0, pa0_); A_PK4(p0, 8, pa1_); A_PK4(p1, 0, pa2_); A_PK4(p1, 8, pa3_); \
        if (__any(alpha_ < 1.f)) { if (hi == 0) al_l[r32] = alpha_; LDS_WAIT(); \
            _Pragma("unroll") for (int d_ = 0; d_ < 4; ++d_) _Pragma("unroll") for (int r = 0; r < 16; ++r) o[d_][r] *= al_l[crow(r, hi)]; } \
        SBAR(); pv_tile<(BF) * SHM_V>(o, vb0, pa0_, pa1_, pa2_, pa3_); } \
        if ((t) + 1 < NT) { VM_WAIT(); A_SWRITE(1 - (BF)); } \
        bg_step(BT, BS, bgbuf, bgsbuf, lane);   \
        LDS_WAIT(); asm volatile("" ::: "memory"); __builtin_amdgcn_s_barrier(); asm volatile("" ::: "memory"); } while (0)
#define A_PK4(P, B_, OUT) do { unsigned a0_ = cvtpk(P[B_ + 0], P[B_ + 1]), a1_ = cvtpk(P[B_ + 2], P[B_ + 3]), b0_ = cvtpk(P[B_ + 4], P[B_ + 5]), b1_ = cvtpk(P[B_ + 6], P[B_ + 7]); \
        auto r0_ = __builtin_amdgcn_permlane32_swap(a0_, b0_, false, false); auto r1_ = __builtin_amdgcn_permlane32_swap(a1_, b1_, false, false); \
        v4u w_ = {r0_[0], r1_[0], r0_[1], r1_[1]}; OUT = __builtin_bit_cast(bf16x8, w_); } while (0)
    asm volatile(".p2align 6\n\ts_nop 0\n\ts_nop 0\n\ts_nop 0\n\ts_nop 0\n\ts_nop 0\n\ts_nop 0\n\ts_nop 0\n\ts_nop 0\n\ts_nop 0\n\ts_nop 0\n\ts_nop 0\n\ts_nop 0\n\ts_nop 0\n\ts_nop 0");
    for (int t = 0; t < NT; t += 2) { A_STEP(t, 0); asm volatile(".p2align 6\n\ts_nop 0\n\ts_nop 0\n\ts_nop 0\n\ts_nop 0\n\ts_nop 0\n\ts_nop 0\n\ts_nop 0\n\ts_nop 0\n\ts_nop 0\n\ts_nop 0\n\ts_nop 0\n\ts_nop 0\n\ts_nop 0\n\ts_nop 0"); A_STEP(t + 1, 1); }
#undef A_STEP
#undef A_PK4
#undef A_SLOAD
#undef A_SWRITE
    if (hi == 0) li_l[r32] = l_reg; LDS_WAIT();
    char* Ow = (char*)(AO + (size_t)(rowbase + qlo) * 6144 + 2048 + h * VH);
    unsigned ooffb = (unsigned)(4 * hi * 6144 + r32) * 2u; asm volatile("" : "+v"(ooffb));
#pragma unroll
    for (int r = 0; r < 16; ++r) { const int orow = crow(r, hi); const float rl = __builtin_amdgcn_rcpf(li_l[orow]);
#pragma unroll
        for (int d0 = 0; d0 < 4; ++d0) { const float v = o[d0][r] * rl; const float vn = __shfl_xor(v, 1);
            if ((r32 & 1) == 0) *(unsigned*)(Ow + ooffb + (((r & 3) + 8 * (r >> 2)) * 6144 + d0 * 32) * 2) = cvtpk(v, vn); } }
    LDS_WAIT(); __syncthreads();
}

__device__ __forceinline__ void gmlp_unit(int b, int n, int g, const bf16* UV, const float* rv, const float* w_s, const float* b_s, const float* g_v, bf16* AO, char* lds, const int wid) {
    const int lane = pg8::lane_id(), tid = wid * 64 + lane, r32 = lane & 31, hi = lane >> 5;
    const int wt = wid & 3, wh = wid >> 2, R0 = b * SEQ + n * 128, C0 = g * 256;
    { const int sr = tid >> 4, sc = (tid & 15) * 8, vst0 = v_st(sr, sc), vst1 = v_st(32 + sr, sc);
      bf16x8 tv[8];
#pragma unroll
      for (int sh = 0; sh < 2; ++sh)
#pragma unroll
          for (int ch = 0; ch < 2; ++ch) { const bf16* p = UV + (size_t)(R0 + sh * 64 + sr) * 4096 + 2048 + C0 + ch * 128 + sc;
              tv[(sh * 2 + ch) * 2] = *(const bf16x8*)p; tv[(sh * 2 + ch) * 2 + 1] = *(const bf16x8*)(p + (size_t)32 * 4096); }
#pragma unroll
      for (int i = 0; i < 4; ++i) { *(bf16x8*)(lds + i * SHM_V + vst0) = tv[2 * i]; *(bf16x8*)(lds + i * SHM_V + vst1) = tv[2 * i + 1]; } }
    LDS_WAIT(); __syncthreads();
    f32x16 o[4] = {};
    const int vb0 = (int)(uintptr_t)lds + wh * SHM_V + v_rd_base(lane);
    const int t = wt * 32 + r32;
    const float* wrow = w_s + ((size_t)g * 128 + t) * 128;
#define G_FRAG(ks, OUT) do { const int s0_ = (ks) * 16 + hi * 8; const f32x4 wa_ = *(const f32x4*)(wrow + s0_), wb_ = *(const f32x4*)(wrow + s0_ + 4); \
        const f32x4 ra_ = *(const f32x4*)(rv + R0 + s0_), rb_ = *(const f32x4*)(rv + R0 + s0_ + 4); float e_[8]; \
        _Pragma("unroll") for (int j = 0; j < 4; ++j) { e_[j] = (s0_ + j <= t) ? wa_[j] * ra_[j] : 0.f; e_[4 + j] = (s0_ + 4 + j <= t) ? wb_[j] * rb_[j] : 0.f; } \
        v4u w_ = {cvtpk(e_[0], e_[1]), cvtpk(e_[2], e_[3]), cvtpk(e_[4], e_[5]), cvtpk(e_[6], e_[7])}; OUT = __builtin_bit_cast(bf16x8, w_); } while (0)
    { bf16x8 pa0, pa1, pa2, pa3; G_FRAG(0, pa0); G_FRAG(1, pa1); G_FRAG(2, pa2); G_FRAG(3, pa3); SBAR(); pv_tile<0>(o, vb0, pa0, pa1, pa2, pa3); }
    if (wt >= 2) { bf16x8 pa0, pa1, pa2, pa3; G_FRAG(4, pa0); G_FRAG(5, pa1); G_FRAG(6, pa2); G_FRAG(7, pa3); SBAR(); pv_tile<2 * SHM_V>(o, vb0, pa0, pa1, pa2, pa3); }
#undef G_FRAG
#pragma unroll
    for (int d0 = 0; d0 < 4; ++d0) { const int c = C0 + wh * 128 + d0 * 32 + r32; const float gv = g_v[c];
#pragma unroll
        for (int r = 0; r < 16; ++r) { const int tr = wt * 32 + crow(r, hi); const size_t row = (size_t)(R0 + tr);
            const float u = __uint_as_float((unsigned)UV[row * 4096 + c] << 16);
            const float v = u * (gv * o[d0][r] + b_s[g * 128 + tr]); const float vn = __shfl_xor(v, 1);
            if ((r32 & 1) == 0) *(unsigned*)(AO + row * 6144 + c) = cvtpk(v, vn); } }
    LDS_WAIT(); __syncthreads();
}

__device__ __forceinline__ void head_norm_rope(v4u (&w)[12], int half, const float* gain, const float* cs, const float* sn, float scale) {
    float ss = 0.f;
#pragma unroll
    for (int j = 0; j < 12; ++j)
#pragma unroll
        for (int e = 0; e < 4; ++e) { const float a = bflo(w[j][e]), b2 = bfhi(w[j][e]); ss += a * a + b2 * b2; }
    ss += __shfl_xor(ss, 1);
    const float rs = scale / sqrtf(ss * (1.0f / 192.0f) + EPS);
    const float* gp = gain + half * 96;
#pragma unroll
    for (int j = 0; j < 4; ++j) {
        const f32x4 g0 = *(const f32x4*)(gp + 8 * j), g1 = *(const f32x4*)(gp + 8 * j + 4);
        w[j] = (v4u){pk2(bflo(w[j][0]) * rs * g0[0], bfhi(w[j][0]) * rs * g0[1]), pk2(bflo(w[j][1]) * rs * g0[2], bfhi(w[j][1]) * rs * g0[3]),
                     pk2(bflo(w[j][2]) * rs * g1[0], bfhi(w[j][2]) * rs * g1[1]), pk2(bflo(w[j][3]) * rs * g1[2], bfhi(w[j][3]) * rs * g1[3])};
    }
#pragma unroll
    for (int j = 4; j < 8; ++j) {
        float a[8], b[8];
        { const f32x4 g0 = *(const f32x4*)(gp + 8 * j), g1 = *(const f32x4*)(gp + 8 * j + 4), h0 = *(const f32x4*)(gp + 8 * j + 32), h1 = *(const f32x4*)(gp + 8 * j + 36);
#pragma unroll
          for (int e = 0; e < 4; ++e) { a[2 * e] = bflo(w[j][e]) * rs; a[2 * e + 1] = bfhi(w[j][e]) * rs; b[2 * e] = bflo(w[j + 4][e]) * rs; b[2 * e + 1] = bfhi(w[j + 4][e]) * rs; }
#pragma unroll
          for (int e = 0; e < 4; ++e) { a[e] *= g0[e]; a[4 + e] *= g1[e]; b[e] *= h0[e]; b[4 + e] *= h1[e]; } }
        if (half) {
            const f32x4 c0 = *(const f32x4*)(cs + 8 * (j - 4)), c1 = *(const f32x4*)(cs + 8 * (j - 4) + 4), s0 = *(const f32x4*)(sn + 8 * (j - 4)), s1 = *(const f32x4*)(sn + 8 * (j - 4) + 4);
#pragma unroll
            for (int e = 0; e < 8; ++e) { const float c_ = e < 4 ? c0[e] : c1[e - 4], s_ = e < 4 ? s0[e] : s1[e - 4]; const float x1 = a[e], x2 = b[e]; a[e] = x1 * c_ - x2 * s_; b[e] = x2 * c_ + x1 * s_; }
        }
        w[j] = (v4u){pk2(a[0], a[1]), pk2(a[2], a[3]), pk2(a[4], a[5]), pk2(a[6], a[7])};
        w[j + 4] = (v4u){pk2(b[0], b[1]), pk2(b[2], b[3]), pk2(b[4], b[5]), pk2(b[6], b[7])};
    }
}

__global__ void __launch_bounds__(NWAVES * 64, 2) hybrid_fwd(Args args) {
    extern __shared__ __attribute__((aligned(16))) unsigned char lds[];
    Frame F;
    F.lds = (LAS unsigned char*)lds;
    F.wave = __builtin_amdgcn_readfirstlane((int)threadIdx.x >> 6);
#define FTID (F.wave * 64 + pg8::lane_id())
    F.G = gridDim.x; { const int bx = blockIdx.x; F.vcu = (F.G % 8 == 0) ? (bx % 8) * (F.G / 8) + bx / 8 : bx; }
    unsigned char* ws = args.ws;
    gu32* ctl = (gu32*)(ws + WS_CTL);
    volatile LAS unsigned* MISC = (volatile LAS unsigned*)(F.lds + MISC_OFF);
    for (int u = FTID; u < (LDS_BYTES - LDSCTL_OFF) / 4; u += NWAVES * 64) ((LAS unsigned*)(F.lds + LDSCTL_OFF))[u] = 0u;
    __syncthreads();
    XcdBarrier bar; bar.bar = (unsigned*)(ctl + CW_BAR); bar.x = 0; bar.st = nullptr; bar.wave = F.wave;
    if (MK_N_LAUNCHES == 1) bar = xcd_barrier_post((unsigned*)(ctl + CW_BAR), MISC + 8, F.wave);
#define GRID_BAR() do { if (MK_N_LAUNCHES == 1) xcd_barrier(bar); } while (0)
    const int lo = args.ph_lo, hi_ph = args.ph_hi;
#define IN(k) (lo <= (k) && (k) < hi_ph && !(DIAG_STOP >= 0 && (k) > DIAG_STOP && (k) < 12))
#define BOTH(k) (IN(k) && IN((k) + 1))

    const float* x = args.in[0]; const float* cnd = args.in[1]; const int* positions = (const int*)args.in[2];
    const float* w_ada = args.in[3]; const float* b_ada = args.in[4]; const float* g_norm1 = args.in[5]; const float* w_in = args.in[6];
    const float* g_v = args.in[7]; const float* w_s = args.in[8]; const float* b_s = args.in[9]; const float* g_q_lat = args.in[10]; const float* g_kv_lat = args.in[11];
    const float* w_uq = args.in[12]; const float* w_ukv = args.in[13]; const float* g_qn = args.in[14]; const float* g_kn = args.in[15];
    const float* w_ba = args.in[16]; const float* w_bb = args.in[17]; const float* w_out = args.in[18]; const float* g_norm2 = args.in[19];
    const float* w_ff1 = args.in[20]; const float* w_ff2 = args.in[21];
    float* out = args.out;
    float* MOD = (float*)(ws + WS_MOD); float* RV = (float*)(ws + WS_STATS); float* RQ = RV + M; float* RKV = RQ + M;
    float* RPE = RKV + M; float* PER = (float*)(ws + WS_MODP);     float* ROPE_C = (float*)(ws + WS_ROPE); float* ROPE_S = ROPE_C + (size_t)M * 32; float* MODP = (float*)(ws + WS_MODP);
    bf16* WIN_T = (bf16*)(ws + WS_WIN); bf16* WUQ_T = (bf16*)(ws + WS_WUQ); bf16* WUKV_T = (bf16*)(ws + WS_WUKV); bf16* WAB_T = (bf16*)(ws + WS_WAB);
    bf16* WOUT_T = (bf16*)(ws + WS_WOUT); bf16* WFF1_T = (bf16*)(ws + WS_WFF1); bf16* WFF2_T = (bf16*)(ws + WS_WFF2);
    bf16* HB = (bf16*)(ws + WS_H); bf16* UV = (bf16*)(ws + WS_UV); bf16* QL = (bf16*)(ws + WS_QL); bf16* KVL = (bf16*)(ws + WS_KVL); bf16* KPE = (bf16*)(ws + WS_KPE);
    bf16* GATES = (bf16*)(ws + WS_GATES); bf16* AO = (bf16*)(ws + WS_AO); bf16* QB = (bf16*)(ws + WS_Q); bf16* KN = (bf16*)(ws + WS_KN); bf16* VB = (bf16*)(ws + WS_V);
    bf16* KB = (bf16*)(ws + WS_K); bf16* MIXED = (bf16*)(ws + WS_MIXED); float* TB = (float*)(ws + WS_T); bf16* F1 = (bf16*)(ws + WS_F1);
    signed char* WOUT8 = (signed char*)(ws + WS_WOUT); signed char* M8 = (signed char*)(ws + WS_M8); float* MSTEP = (float*)(ws + WS_MS); float* CSO = (float*)(ws + WS_CSO); float* CMAXO = (float*)(ws + WS_CMAXO);
    signed char* WG8 = (signed char*)(ws + WS_WG8); signed char* H8 = (signed char*)(ws + WS_H8); float* CMAXP = (float*)(ws + WS_CMAXP); float* CSTEP = (float*)(ws + WS_CS); float* HSTEP = (float*)(ws + WS_HS);
    float* CMAXAB = (float*)(ws + WS_CMAXAB); float* CSAB = (float*)(ws + WS_CSAB); float* SA = (float*)(ws + WS_SA); float* SB = (float*)(ws + WS_SB); signed char* A8 = (signed char*)(ws + WS_A8); signed char* WAB8 = (signed char*)(ws + WS_WAB);
    float* CMAXF = (float*)(ws + WS_CMAXF); float* CSF = (float*)(ws + WS_CSF); signed char* H28 = (signed char*)(ws + WS_H8); signed char* WFF18 = (signed char*)(ws + WS_WFF1);
    const int gw = F.vcu * NWAVES + F.wave, NGW = F.G * NWAVES;

    if (IN(0)) {
        const int ptid = FTID, plane = ptid & 63;
        LAS float* scr = (LAS float*)(F.lds + F.wave * 16384);
        for (int it = gw; it < KSPLIT * 96; it += NGW) {
            const int kc = it / 96, nc = it % 96, k0 = kc * KCH, n0 = nc * 256 + 4 * plane;
#pragma unroll
            for (int j = 0; j < 8; ++j) { const int idx = plane + 64 * j, bb = idx >> 7, kk = idx & 127; const float cv = cnd[bb * DM + k0 + kk]; scr[idx] = cv / (1.0f + __expf(-cv)); }
            LDS_WAIT(); asm volatile("" ::: "memory");
            f32x4 a0 = {0.f, 0.f, 0.f, 0.f}, a1 = a0, a2 = a0, a3 = a0;
            const float* wp = w_ada + (size_t)k0 * NMODC + n0;
#pragma unroll 8
            for (int kk = 0; kk < KCH; ++kk) { const f32x4 w = *(const f32x4*)(wp + (size_t)kk * NMODC);
                a0 += w * scr[kk]; a1 += w * scr[128 + kk]; a2 += w * scr[256 + kk]; a3 += w * scr[384 + kk]; }
            float* mp = MODP + (size_t)(kc * 4) * NMODC + n0;
            *(f32x4*)mp = a0; *(f32x4*)(mp + NMODC) = a1; *(f32x4*)(mp + 2 * NMODC) = a2; *(f32x4*)(mp + 3 * NMODC) = a3;
            LDS_WAIT(); asm volatile("" ::: "memory");
        }
        constexpr int NBF = UV8 ? 50 : 178, I_IN = 64 * NBF, I_UQ = 16 * 192, I_UKV = 8 * 256;
        constexpr int NITEMS = I_IN + I_UQ + I_UKV;
        for (int it = gw; it < NITEMS; it += NGW) {
            int r = it;
            if (r < I_IN) { const int kb = r / NBF, nb = (UV8 ? 128 : 0) + r % NBF; p0_transpose_item(w_in, IN_COLS, WIN_T, DM, 0, nullptr, scr, kb, nb, plane); continue; } r -= I_IN;
            if (r < I_UQ) { p0_transpose_item(w_uq, 6144, WUQ_T, QLORA, 0, g_q_lat, scr, r / 192, r % 192, plane); continue; } r -= I_UQ;
            p0_transpose_item(w_ukv, 8192, WUKV_T, KVLORA, 0, g_kv_lat, scr, r / 256, r % 256, plane);
        }
        for (int it = gw; it < 64 * 64; it += NGW) { const int kb = it >> 6, nc = it & 63;
            CMAXO[(size_t)kb * DM + nc * 64 + plane] = rot_colmax64(w_out + (size_t)(kb * 64) * DM + nc * 64 + plane, DM); }
        for (int it = gw; it < 64 * (FF8 / 64); it += NGW) { const int kb = it / (FF8 / 64), nc = it % (FF8 / 64);
            const float* wp = w_ff1 + (size_t)(kb * 64) * DFF + nc * 64 + plane;
            float w[64];
#pragma unroll
            for (int kk = 0; kk < 64; ++kk) w[kk] = wp[(size_t)kk * DFF];
            had_reg<64>(w);
            float mx = 0.f;
#pragma unroll
            for (int kk = 0; kk < 64; ++kk) mx = fmaxf(mx, fabsf(w[kk]));
            CMAXF[(size_t)kb * DFF + nc * 64 + plane] = mx; }
        for (int it = gw; it < 96 * 64; it += NGW) { const int kb = it >> 6, nc = it & 63;
            const float* wp = (kb < 32 ? w_ba + (size_t)(kb * 64) * DM : w_bb + (size_t)((kb - 32) * 64) * DM) + nc * 64 + plane;
            float w[64];
#pragma unroll
            for (int kk = 0; kk < 64; ++kk) w[kk] = wp[(size_t)kk * DM];
            had_reg<64>(w);
            float mx = 0.f;
#pragma unroll
            for (int kk = 0; kk < 64; ++kk) mx = fmaxf(mx, fabsf(w[kk]));
            CMAXAB[(size_t)kb * DM + nc * 64 + plane] = mx; }
        for (int i = gw * 64 + plane; i < 192 * 512; i += NGW * 64) *(v4u*)(WIN_T + (size_t)OFF_GATE * DM + (size_t)i * 8) = (v4u){0u, 0u, 0u, 0u};
        for (int i = gw * 64 + plane; i < M * 32; i += NGW * 64) { const int row = i >> 5, fi = i & 31; const float ang = (float)positions[row] * args.inv_freq[fi];
            float c_, s_; sincos_acc(ang, c_, s_); ROPE_C[i] = c_; ROPE_S[i] = s_; }
        for (int it = gw; it < 64 * (NQ8 / 64); it += NGW) { const int kb = it / (NQ8 / 64), nc = it % (NQ8 / 64), scol = nc * 64 + (nc >= UV8 / 64 ? OFF_GATE - UV8 : 0);
            CMAXP[(size_t)kb * NQ8 + nc * 64 + plane] = rot_colmax64(w_in + (size_t)(kb * 64) * IN_COLS + scol + plane, IN_COLS); }
        if (BOTH(0)) GRID_BAR();
    }

    if (IN(1)) {
        const int ptid = FTID, plane = ptid & 63;
        for (int wgi = blockIdx.x; wgi < M / 32; wgi += F.G) {
            if (ptid < 384) { const int idx = wgi * 384 + ptid, b2 = idx / NMODC, n = idx % NMODC; const float* mp = MODP + (size_t)b2 * NMODC + n;
                float pv_[KSPLIT];
#pragma unroll
                for (int kc = 0; kc < KSPLIT; ++kc) pv_[kc] = mp[(size_t)kc * 4 * NMODC];
                float s_ = b_ada[n];
#pragma unroll
                for (int kc = 0; kc < KSPLIT; ++kc) s_ += pv_[kc];
                MOD[idx] = s_; }
            if (ptid < NQ8 / 256) { const int n = wgi * (NQ8 / 256) + ptid; float mx = 0.f;
#pragma unroll
                for (int kc = 0; kc < 64; ++kc) mx = fmaxf(mx, CMAXP[(size_t)kc * NQ8 + n]);
                CSTEP[n] = mx * (1.0f / 127.0f); }
            if (ptid >= 64 && ptid < 80) { const int n = wgi * 16 + (ptid - 64); float mx = 0.f;
#pragma unroll
                for (int kc = 0; kc < 64; ++kc) mx = fmaxf(mx, CMAXO[(size_t)kc * DM + n]);
                CSO[n] = mx * (1.0f / 127.0f); }
            if (ptid >= 192 && ptid < 208) { const int n = wgi * 16 + (ptid - 192); float mx = 0.f;
#pragma unroll 8
                for (int kc = 0; kc < 96; ++kc) mx = fmaxf(mx, CMAXAB[(size_t)kc * DM + n]);
                CSAB[n] = mx * (1.0f / 127.0f); }
            if (ptid >= 128 && ptid < 192 && wgi * 64 < FF8) { const int n = wgi * 64 + (ptid - 128); float mx = 0.f;
#pragma unroll
                for (int kc = 0; kc < 64; ++kc) mx = fmaxf(mx, CMAXF[(size_t)kc * DFF + n]);
                CSF[n] = mx * (1.0f / 127.0f); }
        }
        GRID_BAR();
        { LAS float* scr = (LAS float*)(F.lds + F.wave * 16384);
          for (int it = gw; it < 64 * (NQ8 / 32); it += NGW) { const int kb = it / (NQ8 / 32), nb = it % (NQ8 / 32);
              quant_transpose_item(w_in + (nb >= UV8 / 32 ? OFF_GATE - UV8 : 0), IN_COLS, WG8, DM, CSTEP, scr, kb, nb, pg8::lane_id()); }
        }
        LDS_WAIT(); __syncthreads();
        LAS float* modl = (LAS float*)F.lds;
        for (int wgi = blockIdx.x; wgi < M / 32; wgi += F.G) {
            const int bb = wgi >> 6; const float* mb = MOD + (size_t)bb * NMODC;
#pragma unroll
            for (int j = 0; j < 2; ++j) { const int col = 4 * (ptid + 512 * j); const f32x4 g4 = *(const f32x4*)(g_norm1 + col), sh = *(const f32x4*)(mb + col), sc = *(const f32x4*)(mb + DM + col);
                *(LAS f32x4*)(modl + col) = g4 * (sc + 1.0f); *(LAS f32x4*)(modl + DM + col) = sh; }
            LDS_WAIT(); __syncthreads();
#pragma unroll 1
            for (int i = 0; i < 4; ++i) { const int row = wgi * 32 + F.wave * 4 + i; const int pl = pg8::lane_id();
                const f32x4* xr = (const f32x4*)(x + (size_t)row * DM) + pl;
                f32x4 v[16]; float ss = 0.f;
#pragma unroll
                for (int j = 0; j < 16; ++j) { v[j] = xr[64 * j]; ss += (v[j].x * v[j].x + v[j].y * v[j].y) + (v[j].z * v[j].z + v[j].w * v[j].w); }
                const float r = 1.0f / sqrtf(wave_sum(ss) * (1.0f / DM) + EPS);
                float hm = 0.f;
#pragma unroll
                for (int j = 0; j < 16; ++j) { const int col = 4 * (pl + 64 * j);
                    const f32x4 ga = *(const LAS f32x4*)(modl + col), sh = *(const LAS f32x4*)(modl + DM + col);
                    const f32x4 hv = v[j] * r * ga + sh; v[j] = hv;
                    *(v2u*)(HB + (size_t)row * DM + col) = (v2u){pk2(hv.x, hv.y), pk2(hv.z, hv.w)}; }
#pragma unroll
                for (int j = 0; j < 16; ++j) { f32x4 t = had4(v[j]);
#pragma unroll
                    for (int e = 0; e < 4; ++e) { float x_ = t[e]; x_ = had_x(x_, 1, pl); x_ = had_x(x_, 2, pl); x_ = had_x(x_, 4, pl); x_ = had_x(x_, 8, pl); t[e] = x_; }
                    v[j] = t; hm = fmaxf(fmaxf(hm, fmaxf(fabsf(t.x), fabsf(t.y))), fmaxf(fabsf(t.z), fabsf(t.w))); }
#pragma unroll
                for (int o_ = 1; o_ < 64; o_ <<= 1) hm = fmaxf(hm, __shfl_xor(hm, o_));
                const float inv = hm > 0.f ? 127.0f / hm : 0.f;
                if (pl == 0) HSTEP[row] = hm * (1.0f / (127.0f * 64.0f));
#pragma unroll
                for (int j = 0; j < 16; ++j) { const int col = 4 * (pl + 64 * j);
                    const unsigned q0 = __float_as_uint(__builtin_fmaf(v[j].x, inv, 12582912.0f)), q1 = __float_as_uint(__builtin_fmaf(v[j].y, inv, 12582912.0f)), q2 = __float_as_uint(__builtin_fmaf(v[j].z, inv, 12582912.0f)), q3 = __float_as_uint(__builtin_fmaf(v[j].w, inv, 12582912.0f));
                    *(unsigned*)(H8 + (size_t)row * DM + col) = __builtin_amdgcn_perm(__builtin_amdgcn_perm(q3, q2, 0x0c0c0400u), __builtin_amdgcn_perm(q1, q0, 0x0c0c0400u), 0x05040100u); } }
            LDS_WAIT(); __syncthreads();
        }
        if (BOTH(1)) GRID_BAR();
    }

    if (IN(2)) {
        const int ptid = FTID, plane = ptid & 63;
        { pg8::Gemm g{HB, WIN_T + (size_t)UV8 * DM, DM, DM, M, NP_GATE - UV8, DM}; pg8::StaticOrder S; S.init(M, NP_GATE - UV8, F.G, (int)blockIdx.x);
          pg8::EpiProj E{UV, QL, KVL, KPE, GATES, UV8 / 256};
          pg8::gemm_phase<pg8::EpiProj, pg8::StaticOrder>(F.lds, g, S, E, F.wave); }
        { pg8::Gemm g{(const bf16*)H8, (const bf16*)WG8, DM / 2, DM / 2, M, NQ8, DM / 2}; pg8::StaticOrder S; S.init(M, NQ8, F.G, (int)blockIdx.x);
          pg8::EpiGateI8 E{UV, GATES, HSTEP, CSTEP};
          pg8::gemm_phase<pg8::EpiGateI8, pg8::StaticOrder, PG8_ALIGN, PG8_SP2, true>(F.lds, g, S, E, F.wave); }
        if (BOTH(2)) GRID_BAR();
    }

    if (IN(3)) {
        const int ptid = FTID, plane = ptid & 63;
        for (int row = gw; row < M; row += NGW) {
            float sv = 0.f, sq = 0.f, sk = 0.f;
            const v4u* pv_ = (const v4u*)(UV + (size_t)row * 4096 + 2048) + plane;
#pragma unroll
            for (int j = 0; j < 4; ++j) { const v4u w = pv_[64 * j];
#pragma unroll
                for (int e = 0; e < 4; ++e) { const float a = bflo(w[e]), b2 = bfhi(w[e]); sv += a * a + b2 * b2; } }
            const v4u* pq_ = (const v4u*)(QL + (size_t)row * 1024) + plane;
#pragma unroll
            for (int j = 0; j < 2; ++j) { const v4u w = pq_[64 * j];
#pragma unroll
                for (int e = 0; e < 4; ++e) { const float a = bflo(w[e]), b2 = bfhi(w[e]); sq += a * a + b2 * b2; } }
            { const v4u w = *((const v4u*)(KVL + (size_t)row * 512) + plane);
#pragma unroll
                for (int e = 0; e < 4; ++e) { const float a = bflo(w[e]), b2 = bfhi(w[e]); sk += a * a + b2 * b2; } }
            sv = wave_sum(sv); sq = wave_sum(sq); sk = wave_sum(sk);
            float spe = 0.f;
            { const unsigned wv = (plane < 32) ? *((const unsigned*)(KPE + (size_t)row * 256) + plane) : 0u; const float e0 = bflo(wv), e1 = bfhi(wv); spe = e0 * e0 + e1 * e1;
              const int el = 2 * (plane & 31), i = el & 31; const float a0 = e0 * g_kn[128 + el], a1 = e1 * g_kn[129 + el];
              const float b0 = __shfl_xor(a0, 16), b1 = __shfl_xor(a1, 16);
              const float c0 = ROPE_C[(size_t)row * 32 + i], c1 = ROPE_C[(size_t)row * 32 + i + 1], s0 = ROPE_S[(size_t)row * 32 + i], s1 = ROPE_S[(size_t)row * 32 + i + 1];
              const float o0 = (el < 32) ? a0 * c0 - b0 * s0 : a0 * c0 + b0 * s0, o1 = (el < 32) ? a1 * c1 - b1 * s1 : a1 * c1 + b1 * s1;
              if (plane < 32) *(pg8::f32x2*)(PER + (size_t)row * 64 + el) = (pg8::f32x2){o0, o1}; }
            spe = wave_sum(spe);
            if (plane == 0) { RV[row] = 1.0f / sqrtf(sv * (1.0f / GMW) + EPS); RQ[row] = 1.0f / sqrtf(sq * (1.0f / QLORA) + EPS); RKV[row] = 1.0f / sqrtf(sk * (1.0f / KVLORA) + EPS); RPE[row] = spe; }
        }
        if (BOTH(3)) GRID_BAR();
    }

    if (IN(4)) {
        const int ptid = FTID, plane = ptid & 63;
        { pg8::Gemm g{QL, WUQ_T, QLORA, QLORA, M, NH * QKH, QLORA}; pg8::StaticOrder S; S.init(M, NH * QKH, F.G, (int)blockIdx.x);
          pg8::EpiRowScale<0> E{QB, NH * QKH, RQ};
          pg8::gemm_phase<pg8::EpiRowScale<0>, pg8::StaticOrder>(F.lds, g, S, E, F.wave); }
        { pg8::Gemm g{KVL, WUKV_T, KVLORA, KVLORA, M, NH * 256, KVLORA}; pg8::StaticOrder S; S.init(M, NH * 256, F.G, (int)blockIdx.x);
          pg8::EpiKV E{KB, VB, RKV, RPE, PER, g_kn, (PG8_LAS float*)(F.lds + RING_BYTES + 1024)};
          pg8::gemm_phase<pg8::EpiKV, pg8::StaticOrder>(F.lds, g, S, E, F.wave); }
        for (int u = F.vcu; u < BATCH * 16 * 8; u += F.G) { const int g_ = u & 7, n_ = (u >> 3) & 15, b_ = u >> 7;
            gmlp_unit(b_, n_, g_, UV, RV, w_s, b_s, g_v, AO, (char*)lds, F.wave); }
        if (BOTH(4)) GRID_BAR();
    }


    if (IN(6)) {
        const int ptid = FTID, plane = ptid & 63;
        const BgSrc BT{ws}; constexpr int ND = BG_ND;
        const int per = (ND + F.G - 1) / F.G;
        BgState BS; BS.cur = -1; BS.next = F.wave * F.G + F.vcu; BS.end = ND; BS.stride = NWAVES * F.G; (void)per;
        LAS unsigned char* bgbuf = F.lds + 86016 + F.wave * 8192; LAS unsigned char* bgsbuf = F.lds + 151552 + F.wave * 256;
        for (int it = F.vcu; it < BATCH * NH * 4; it += F.G) { const int bh = it >> 2, p = it & 3;
            attn_unit(bh >> 5, bh & 31, p, QB, KB, VB, AO, (char*)lds, g_qn, ROPE_C, ROPE_S, BT, BS, bgbuf, bgsbuf, F.wave);
            attn_unit(bh >> 5, bh & 31, 7 - p, QB, KB, VB, AO, (char*)lds, g_qn, ROPE_C, ROPE_S, BT, BS, bgbuf, bgsbuf, F.wave); }
        while (BS.cur >= 0 || BS.next < BS.end) bg_step(BT, BS, bgbuf, bgsbuf, plane);
        if (BOTH(6)) GRID_BAR();
    }

    if (IN(7)) {
        const int ptid = FTID, plane = ptid & 63;
        for (int row = gw; row < M; row += NGW) {
            const v4u* ar = (const v4u*)(AO + (size_t)row * 6144) + plane;
            v4u w[12];
#pragma unroll
            for (int j = 0; j < 12; ++j) w[j] = ar[64 * j];
            float ha = 0.f, hb = 0.f; float f[12][8];
#pragma unroll
            for (int j = 0; j < 12; ++j) {
#pragma unroll
                for (int e = 0; e < 4; ++e) { f[j][2 * e] = bflo(w[j][e]); f[j][2 * e + 1] = bfhi(w[j][e]); }
                had_reg<8>(f[j]);
#pragma unroll
                for (int e = 0; e < 8; ++e) { float x_ = f[j][e]; x_ = had_x(x_, 1, plane); x_ = had_x(x_, 2, plane); x_ = had_x(x_, 4, plane); f[j][e] = x_;
                    if (j < 4) ha = fmaxf(ha, fabsf(x_)); else hb = fmaxf(hb, fabsf(x_)); } }
#pragma unroll
            for (int o_ = 1; o_ < 64; o_ <<= 1) { ha = fmaxf(ha, __shfl_xor(ha, o_)); hb = fmaxf(hb, __shfl_xor(hb, o_)); }
            const float inva = ha > 0.f ? 127.0f / ha : 0.f, invb = hb > 0.f ? 127.0f / hb : 0.f;
            if (plane == 0) { SA[row] = ha * (1.0f / (127.0f * 64.0f)); SB[row] = hb * (1.0f / (127.0f * 64.0f)); }
#pragma unroll
            for (int j = 0; j < 12; ++j) { const float inv = j < 4 ? inva : invb; unsigned qv[8];
#pragma unroll
                for (int e = 0; e < 8; ++e) qv[e] = __float_as_uint(__builtin_fmaf(f[j][e], inv, 12582912.0f));
                const unsigned a01 = __builtin_amdgcn_perm(qv[1], qv[0], 0x0c0c0400u), a23 = __builtin_amdgcn_perm(qv[3], qv[2], 0x0c0c0400u), a45 = __builtin_amdgcn_perm(qv[5], qv[4], 0x0c0c0400u), a67 = __builtin_amdgcn_perm(qv[7], qv[6], 0x0c0c0400u);
                *(v2u*)(A8 + (size_t)row * 6144 + 8 * (plane + 64 * j)) = (v2u){__builtin_amdgcn_perm(a23, a01, 0x05040100u), __builtin_amdgcn_perm(a67, a45, 0x05040100u)}; }
        }
        GRID_BAR();
        pg8::Gemm g{(const bf16*)A8, (const bf16*)WAB8, 3072, 3072, M, DM, 3072}; pg8::StaticOrder S; S.init(M, DM, F.G, (int)blockIdx.x);
        pg8::EpiMixI8 E{GATES, MIXED, 1024 / 64, SA, SB, CSAB};
        pg8::gemm_phase<pg8::EpiMixI8, pg8::StaticOrder, PG8_ALIGN, PG8_SP2, true>(F.lds, g, S, E, F.wave);
        if (BOTH(7)) GRID_BAR();
    }

    if (IN(8)) {
        const int ptid = FTID, plane = ptid & 63;
        for (int row = gw; row < M; row += NGW) {
            const v4u* mr = (const v4u*)(MIXED + (size_t)row * DM) + plane;
            v4u w[8];
#pragma unroll
            for (int j = 0; j < 8; ++j) w[j] = mr[64 * j];
            float hm = 0.f; float f[8][8];
#pragma unroll
            for (int j = 0; j < 8; ++j) {
#pragma unroll
                for (int e = 0; e < 4; ++e) { f[j][2 * e] = bflo(w[j][e]); f[j][2 * e + 1] = bfhi(w[j][e]); }
                had_reg<8>(f[j]);
#pragma unroll
                for (int e = 0; e < 8; ++e) { float x_ = f[j][e]; x_ = had_x(x_, 1, plane); x_ = had_x(x_, 2, plane); x_ = had_x(x_, 4, plane); f[j][e] = x_; hm = fmaxf(hm, fabsf(x_)); } }
#pragma unroll
            for (int o_ = 1; o_ < 64; o_ <<= 1) hm = fmaxf(hm, __shfl_xor(hm, o_));
            const float inv = hm > 0.f ? 127.0f / hm : 0.f;
            if (plane == 0) MSTEP[row] = hm * (1.0f / (127.0f * 64.0f));
#pragma unroll
            for (int j = 0; j < 8; ++j) { unsigned qv[8];
#pragma unroll
                for (int e = 0; e < 8; ++e) qv[e] = __float_as_uint(__builtin_fmaf(f[j][e], inv, 12582912.0f));
                const unsigned a01 = __builtin_amdgcn_perm(qv[1], qv[0], 0x0c0c0400u), a23 = __builtin_amdgcn_perm(qv[3], qv[2], 0x0c0c0400u), a45 = __builtin_amdgcn_perm(qv[5], qv[4], 0x0c0c0400u), a67 = __builtin_amdgcn_perm(qv[7], qv[6], 0x0c0c0400u);
                *(v2u*)(M8 + (size_t)row * DM + 8 * (plane + 64 * j)) = (v2u){__builtin_amdgcn_perm(a23, a01, 0x05040100u), __builtin_amdgcn_perm(a67, a45, 0x05040100u)}; }
        }
        GRID_BAR();
        pg8::Gemm g{(const bf16*)M8, (const bf16*)WOUT8, DM / 2, DM / 2, M, DM, DM / 2}; pg8::StaticOrder S; S.init(M, DM, F.G, (int)blockIdx.x);
        pg8::EpiResI8 E{x, out, MOD + 2 * DM, MSTEP, CSO};
        pg8::gemm_phase<pg8::EpiResI8, pg8::StaticOrder, PG8_ALIGN, PG8_SP2, true>(F.lds, g, S, E, F.wave);
        if (BOTH(8)) GRID_BAR();
    }

    if (IN(9)) {
        const int ptid = FTID, plane = ptid & 63;
        LAS float* modl = (LAS float*)F.lds;
        for (int wgi = blockIdx.x; wgi < M / 32; wgi += F.G) {
            const int bb = wgi >> 6; const float* mb = MOD + (size_t)bb * NMODC;
#pragma unroll
            for (int j = 0; j < 2; ++j) { const int col = 4 * (ptid + 512 * j); const f32x4 g4 = *(const f32x4*)(g_norm2 + col), sh = *(const f32x4*)(mb + 3 * DM + col), sc = *(const f32x4*)(mb + 4 * DM + col);
                *(LAS f32x4*)(modl + col) = g4 * (sc + 1.0f); *(LAS f32x4*)(modl + DM + col) = sh; }
            LDS_WAIT(); __syncthreads();
#pragma unroll 1
            for (int i = 0; i < 4; ++i) { const int row = wgi * 32 + F.wave * 4 + i; const int pl = pg8::lane_id();
                const f32x4* xr = (const f32x4*)(out + (size_t)row * DM) + pl;
                f32x4 v[16]; float ss = 0.f;
#pragma unroll
                for (int j = 0; j < 16; ++j) { v[j] = xr[64 * j]; ss += (v[j].x * v[j].x + v[j].y * v[j].y) + (v[j].z * v[j].z + v[j].w * v[j].w); }
                const float r = 1.0f / sqrtf(wave_sum(ss) * (1.0f / DM) + EPS);
                float hm = 0.f;
#pragma unroll
                for (int j = 0; j < 16; ++j) { const int col = 4 * (pl + 64 * j);
                    const f32x4 ga = *(const LAS f32x4*)(modl + col), sh = *(const LAS f32x4*)(modl + DM + col);
                    const f32x4 hv = v[j] * r * ga + sh; v[j] = hv;
                    if constexpr (FF8 < DFF) *(v2u*)(HB + (size_t)row * DM + col) = (v2u){pk2(hv.x, hv.y), pk2(hv.z, hv.w)}; }
#pragma unroll
                for (int j = 0; j < 16; ++j) { f32x4 t = had4(v[j]);
#pragma unroll
                    for (int e = 0; e < 4; ++e) { float x_ = t[e]; x_ = had_x(x_, 1, pl); x_ = had_x(x_, 2, pl); x_ = had_x(x_, 4, pl); x_ = had_x(x_, 8, pl); t[e] = x_; }
                    v[j] = t; hm = fmaxf(fmaxf(hm, fmaxf(fabsf(t.x), fabsf(t.y))), fmaxf(fabsf(t.z), fabsf(t.w))); }
#pragma unroll
                for (int o_ = 1; o_ < 64; o_ <<= 1) hm = fmaxf(hm, __shfl_xor(hm, o_));
                const float inv = hm > 0.f ? 127.0f / hm : 0.f;
                if (pl == 0) HSTEP[row] = hm * (1.0f / (127.0f * 64.0f));
#pragma unroll
                for (int j = 0; j < 16; ++j) { const int col = 4 * (pl + 64 * j);
                    const unsigned q0 = __float_as_uint(__builtin_fmaf(v[j].x, inv, 12582912.0f)), q1 = __float_as_uint(__builtin_fmaf(v[j].y, inv, 12582912.0f)), q2 = __float_as_uint(__builtin_fmaf(v[j].z, inv, 12582912.0f)), q3 = __float_as_uint(__builtin_fmaf(v[j].w, inv, 12582912.0f));
                    *(unsigned*)(H28 + (size_t)row * DM + col) = __builtin_amdgcn_perm(__builtin_amdgcn_perm(q3, q2, 0x0c0c0400u), __builtin_amdgcn_perm(q1, q0, 0x0c0c0400u), 0x05040100u); } }
            LDS_WAIT(); __syncthreads();
        }
        if (BOTH(9)) GRID_BAR();
    }

    if (IN(10)) {
        const int ptid = FTID, plane = ptid & 63;
        { pg8::Gemm g{(const bf16*)H28, (const bf16*)WFF18, DM / 2, DM / 2, M, FF8, DM / 2}; pg8::StaticOrder S; S.init(M, FF8, F.G, (int)blockIdx.x);
          pg8::EpiActI8<3> E{F1, DFF, HSTEP, CSF};
          pg8::gemm_phase<pg8::EpiActI8<3>, pg8::StaticOrder, PG8_ALIGN, PG8_SP2, true>(F.lds, g, S, E, F.wave); }
        if constexpr (FF8 < DFF) { pg8::Gemm g{HB, WFF1_T + (size_t)FF8 * DM, DM, DM, M, DFF - FF8, DM}; pg8::StaticOrder S; S.init(M, DFF - FF8, F.G, (int)blockIdx.x);
          pg8::EpiRowScale<3> E{F1 + FF8, DFF, nullptr};
          pg8::gemm_phase<pg8::EpiRowScale<3>, pg8::StaticOrder>(F.lds, g, S, E, F.wave); }
        if (BOTH(10)) GRID_BAR();
    }

    if (IN(11)) {
        const int ptid = FTID, plane = ptid & 63;
        pg8::Gemm g{F1, WFF2_T, DFF, DFF, M, DM, DFF}; pg8::StaticOrder S; S.init(M, DM, F.G, (int)blockIdx.x);
        pg8::EpiRes E{out, out, MOD + 5 * DM};
        pg8::gemm_phase<pg8::EpiRes, pg8::StaticOrder>(F.lds, g, S, E, F.wave);
    }
    if (DIAG_STOP >= 0 && IN(12)) {
        const int ptid = FTID, plane = ptid & 63;
        GRID_BAR();
        for (int row = gw; row < M; row += NGW) {
#pragma unroll 1
            for (int c = plane; c < DM; c += 64) {
                float v;
                if (DIAG_STOP == 6) { v = (c < 2048) ? bflo(AO[(size_t)row * 6144 + c]) : bflo(AO[(size_t)row * 6144 + c]) + bflo(AO[(size_t)row * 6144 + c + 2048]); }
                else if (DIAG_STOP == 2) { v = bflo(GATES[(size_t)row * 8192 + c]) + bflo(GATES[(size_t)row * 8192 + 4096 + c]); }
                else if (DIAG_STOP == 5) { v = bflo(QB[(size_t)row * 6144 + c]) + bflo(KB[(size_t)row * 6144 + c]) + bflo(VB[(size_t)row * 4096 + c]) + ((c < 2048) ? (bflo(QB[(size_t)row * 6144 + 4096 + c]) + bflo(KB[(size_t)row * 6144 + 4096 + c])) : 0.f); }
                else if (DIAG_STOP == 0) { v = bflo(WIN_T[(size_t)(NP_GATE + row) * DM + c]); }
                else if (DIAG_STOP == 7) { v = bflo(MIXED[(size_t)row * 4096 + c]); }
                else if (DIAG_STOP == 8) { v = 4.0f * (bflo(MIXED[(size_t)row * DM + c]) - (float)M8[(size_t)row * DM + c] * MSTEP[row]); }
                else if (DIAG_STOP == 10) { v = bflo(F1[(size_t)row * DFF + c]) + bflo(F1[(size_t)row * DFF + 4096 + c]) + bflo(F1[(size_t)row * DFF + 8192 + c]) + bflo(F1[(size_t)row * DFF + 12288 + c]); }
                else { v = 4.0f * (bflo(HB[(size_t)row * 4096 + c]) - (float)H8[(size_t)row * DM + c] * HSTEP[row]); }
                out[(size_t)row * DM + c] = v;
            }
        }
    }
#undef IN
#undef BOTH
#undef GRID_BAR
}

extern "C" void kernel_launch(void* const* d_in, const int* in_sizes, int n_in, void* d_out, int out_size, void* d_ws, size_t ws_size, hipStream_t stream) {
    static int grid = 0;
    if (grid == 0) {
        if (n_in != 22 || in_sizes[0] != M * DM || out_size != M * DM || ws_size < WS_END) { fprintf(stderr, "kernel_launch: shape / workspace mismatch (n_in %d, ws %zu, need %zu)\n", n_in, ws_size, (size_t)WS_END); grid = -1; return; }
        int dev = 0, cus = 0, per_cu = 0;
        if (hipGetDevice(&dev) != hipSuccess || hipDeviceGetAttribute(&cus, hipDeviceAttributeMultiprocessorCount, dev) != hipSuccess) { grid = -1; return; }
        if (hipFuncSetAttribute((const void*)hybrid_fwd, hipFuncAttributeMaxDynamicSharedMemorySize, LDS_BYTES) != hipSuccess) { fprintf(stderr, "kernel_launch: hipFuncSetAttribute failed\n"); grid = -1; return; }
        if (hipOccupancyMaxActiveBlocksPerMultiprocessor(&per_cu, (const void*)hybrid_fwd, NWAVES * 64, LDS_BYTES) != hipSuccess || per_cu < 1)
            fprintf(stderr, "kernel_launch: note: occupancy query reports %d workgroups per CU\n", per_cu);
        (void)hipGetLastError();
        grid = cus;
    }
    if (grid < 0) return;
    if (hipMemsetAsync((char*)d_ws + WS_CTL, 0, CTL_ZERO_BYTES, stream) != hipSuccess) { fprintf(stderr, "kernel_launch: memset failed\n"); return; }
    Args a{};
    for (int i = 0; i < 22; ++i) a.in[i] = (const float*)d_in[i];
    a.out = (float*)d_out; a.ws = (unsigned char*)d_ws;
    for (int i = 0; i < 32; ++i) { const float e = (float)(2 * i) / 64.0f; const float p = powf(10000.0f, e); a.inv_freq[i] = 1.0f / p; }
    constexpr int NPH = (DIAG_STOP >= 0) ? 13 : 12;
    for (int li = 0; li < ((MK_N_LAUNCHES == 1) ? 1 : NPH); ++li) {
        a.ph_lo = (MK_N_LAUNCHES == 1) ? 0 : li; a.ph_hi = (MK_N_LAUNCHES == 1) ? NPH : li + 1;
        if (DIAG_STOP >= 0 && MK_N_LAUNCHES != 1 && li > DIAG_STOP && li < 12) continue;
        hipLaunchKernelGGL(hybrid_fwd, dim3(grid), dim3(NWAVES * 64), LDS_BYTES, stream, a);
        const hipError_t le = hipPeekAtLastError();
        if (le != hipSuccess) { fprintf(stderr, "kernel_launch: launch %d failed: %s\n", li, hipGetErrorName(le)); break; }
    }
    if (PROBE_REDO >= 0) { a.ph_lo = PROBE_REDO; a.ph_hi = PROBE_REDO + 1; hipLaunchKernelGGL(hybrid_fwd, dim3(grid), dim3(NWAVES * 64), LDS_BYTES, stream, a); }
}
```
